# Optimizing an MI355X kernel written in HIP

```python
import math
import jax, jax.numpy as jnp
from jax import lax
import numpy as np

D_MODEL = 2048
BATCH = 4
SEQ = 4096
DEPTH = 1

MIX_WIDTH = D_MODEL
BLOCK = 128
EPS = 1e-6

SWA_HEADS = 16
SWA_KV_HEADS = 2
SWA_HEAD_DIM = 64
SWA_GROUP = SWA_HEADS // SWA_KV_HEADS
WINDOW = 128

REL_BUCKETS = 32
REL_MAX_DIST = 128

MLA_HEADS = 8
MLA_Q_RANK = 384
MLA_KV_RANK = 128
MLA_NOPE_DIM = 128
MLA_ROPE_DIM = 64
MLA_V_DIM = 128
MLA_QK_DIM = MLA_NOPE_DIM + MLA_ROPE_DIM
ROPE_THETA = 10000.0

D_FF = 4 * D_MODEL

SWA_Q_COLS = SWA_HEADS * SWA_HEAD_DIM
SWA_KV_COLS = SWA_KV_HEADS * SWA_HEAD_DIM
OFF_SWA_Q = 0
OFF_SWA_K = OFF_SWA_Q + SWA_Q_COLS
OFF_SWA_V = OFF_SWA_K + SWA_KV_COLS
OFF_MLA_CQ = OFF_SWA_V + SWA_KV_COLS
OFF_MLA_CKV = OFF_MLA_CQ + MLA_Q_RANK
OFF_MLA_KR = OFF_MLA_CKV + MLA_KV_RANK
IN_COLS = OFF_MLA_KR + MLA_ROPE_DIM
SWA_OUT = SWA_HEADS * SWA_HEAD_DIM
MLA_OUT = MLA_HEADS * MLA_V_DIM

kernel_name = "hymba_swa_sink_mla_adaln_layer"


def rmsnorm(x, g):
    x32 = x.astype(jnp.float32)
    y = x32 * lax.rsqrt(jnp.mean(x32 * x32, axis=-1, keepdims=True) + EPS)
    return y.astype(x.dtype) * g


def t5_causal_bucket(dist):
    n = jnp.maximum(dist, 0)
    max_exact = REL_BUCKETS // 2
    is_small = n < max_exact
    nf = jnp.maximum(n, 1).astype(jnp.float32)
    large = max_exact + (jnp.log(nf / max_exact) / math.log(REL_MAX_DIST / max_exact)
                         * (REL_BUCKETS - max_exact)).astype(jnp.int32)
    large = jnp.minimum(large, REL_BUCKETS - 1)
    return jnp.where(is_small, n, large)


def rope(x, positions):
    half = x.shape[-1] // 2
    inv_freq = ROPE_THETA ** (-jnp.arange(half, dtype=jnp.float32) / half)
    ang = positions.astype(jnp.float32)[:, None] * inv_freq[None, :]
    extra = x.ndim - 3
    ang = ang.reshape((1, ang.shape[0]) + (1,) * extra + (half,))
    cos = jnp.cos(ang).astype(x.dtype)
    sin = jnp.sin(ang).astype(x.dtype)
    x1, x2 = x[..., :half], x[..., half:]
    return jnp.concatenate([x1 * cos - x2 * sin, x2 * cos + x1 * sin], axis=-1)


def swa_sink_attention(q, k, v, sinks, rel_bias):
    B, S = q.shape[0], q.shape[1]
    nb = S // BLOCK
    qb = q.reshape(B, nb, BLOCK, SWA_KV_HEADS, SWA_GROUP, SWA_HEAD_DIM)
    kb = k.reshape(B, nb, BLOCK, SWA_KV_HEADS, SWA_HEAD_DIM)
    vb = v.reshape(B, nb, BLOCK, SWA_KV_HEADS, SWA_HEAD_DIM)
    zero = jnp.zeros_like(kb[:, :1])
    k_band = jnp.concatenate([jnp.concatenate([zero, kb[:, :-1]], axis=1), kb], axis=2)
    v_band = jnp.concatenate([jnp.concatenate([zero, vb[:, :-1]], axis=1), vb], axis=2)
    s = jnp.einsum('bnqhgd,bnkhd->bnhgqk', qb, k_band).astype(jnp.float32) * (SWA_HEAD_DIM ** -0.5)

    q_loc = jnp.arange(BLOCK)[:, None]
    k_loc = jnp.arange(2 * BLOCK)[None, :]
    dist = q_loc + BLOCK - k_loc
    in_window = (dist >= 0) & (dist < WINDOW)
    blk = jnp.arange(nb)[:, None]
    key_valid = (blk * BLOCK - BLOCK + k_loc) >= 0
    mask = in_window[None] & key_valid[:, None, :]

    bias = rel_bias.astype(jnp.float32)[t5_causal_bucket(dist)]
    bias = bias.transpose(2, 0, 1).reshape(SWA_KV_HEADS, SWA_GROUP, BLOCK, 2 * BLOCK)
    s = s + bias[None, None]
    s = jnp.where(mask[None, :, None, None], s, -jnp.inf)

    sink = sinks.astype(jnp.float32).reshape(SWA_KV_HEADS, SWA_GROUP)[None, None, :, :, None, None]
    m = jnp.maximum(jnp.max(s, axis=-1, keepdims=True), sink)
    p = jnp.exp(s - m)
    p = p / (jnp.sum(p, axis=-1, keepdims=True) + jnp.exp(sink - m))
    o = jnp.einsum('bnhgqk,bnkhd->bnqhgd', p.astype(v.dtype), v_band)
    return o.reshape(B, S, SWA_OUT)


def mla_attention(q_nope, q_rope, k_nope, k_rope, v):
    B, S = q_nope.shape[0], q_nope.shape[1]
    nb = S // BLOCK
    qn = q_nope.reshape(B, nb, BLOCK, MLA_HEADS, MLA_NOPE_DIM).transpose(1, 0, 2, 3, 4)
    qr = q_rope.reshape(B, nb, BLOCK, MLA_HEADS, MLA_ROPE_DIM).transpose(1, 0, 2, 3, 4)
    key_pos = jnp.arange(S)
    scale = MLA_QK_DIM ** -0.5

    def one_block(args):
        i, qn_i, qr_i = args
        s = (jnp.einsum('bqhd,bkhd->bhqk', qn_i, k_nope)
             + jnp.einsum('bqhd,bkd->bhqk', qr_i, k_rope)).astype(jnp.float32) * scale
        q_pos = i * BLOCK + jnp.arange(BLOCK)
        causal = key_pos[None, :] <= q_pos[:, None]
        s = jnp.where(causal[None, None], s, -jnp.inf)
        p = jax.nn.softmax(s, axis=-1)
        return jnp.einsum('bhqk,bkhd->bqhd', p.astype(v.dtype), v)

    o = lax.map(one_block, (jnp.arange(nb), qn, qr))
    return o.transpose(1, 0, 2, 3, 4).reshape(B, S, MLA_OUT)


def setup_inputs(seed: int = 0) -> dict:
    key = jax.random.key(seed)
    ks = jax.random.split(key, 20)
    f32 = jnp.float32
    nrm = lambda k, shape, s: jax.random.normal(k, shape, f32) * s
    return {
        "x": nrm(ks[0], (BATCH, SEQ, D_MODEL), 1.0),
        "c": nrm(ks[1], (BATCH, D_MODEL), 1.0),
        "w_mod": nrm(ks[2], (DEPTH, D_MODEL, 6 * D_MODEL), 0.5 * D_MODEL ** -0.5),
        "b_mod": nrm(ks[3], (DEPTH, 6 * D_MODEL), 0.01),
        "attn_norm_g": 1.0 + nrm(ks[4], (DEPTH, D_MODEL), 0.02),
        "w_in": nrm(ks[5], (DEPTH, D_MODEL, IN_COLS), D_MODEL ** -0.5),
        "swa_sinks": nrm(ks[6], (DEPTH, SWA_HEADS), 1.0),
        "rel_bias": nrm(ks[7], (REL_BUCKETS, SWA_HEADS), 0.5),
        "mla_q_norm_g": 1.0 + nrm(ks[8], (DEPTH, MLA_Q_RANK), 0.02),
        "w_uq": nrm(ks[9], (DEPTH, MLA_Q_RANK, MLA_HEADS * MLA_QK_DIM), MLA_Q_RANK ** -0.5),
        "mla_kv_norm_g": 1.0 + nrm(ks[10], (DEPTH, MLA_KV_RANK), 0.02),
        "w_ukv": nrm(ks[11], (DEPTH, MLA_KV_RANK, MLA_HEADS * (MLA_NOPE_DIM + MLA_V_DIM)), MLA_KV_RANK ** -0.5),
        "w_out": nrm(ks[12], (DEPTH, MIX_WIDTH, D_MODEL), MIX_WIDTH ** -0.5),
        "mlp_norm_g": 1.0 + nrm(ks[13], (DEPTH, D_MODEL), 0.02),
        "w_ff1": nrm(ks[14], (DEPTH, D_MODEL, D_FF), D_MODEL ** -0.5),
        "w_ff2": nrm(ks[15], (DEPTH, D_FF, D_MODEL), D_FF ** -0.5),
        "final_norm_g": 1.0 + nrm(ks[16], (D_MODEL,), 0.02),
    }


def reference(x, c, w_mod, b_mod, attn_norm_g, w_in, swa_sinks, rel_bias, mla_q_norm_g, w_uq,
              mla_kv_norm_g, w_ukv, w_out, mlp_norm_g, w_ff1, w_ff2, final_norm_g):
    B, S, _ = x.shape
    positions = jnp.arange(S)
    c_act = jax.nn.silu(c)
    for l in range(DEPTH):
        mod = c_act @ w_mod[l] + b_mod[l]
        sh1, sc1, g1, sh2, sc2, g2 = [m[:, None, :] for m in jnp.split(mod, 6, axis=-1)]

        h = rmsnorm(x, attn_norm_g[l]) * (1.0 + sc1) + sh1
        proj = jnp.einsum('bsd,df->bsf', h, w_in[l])

        q_a = proj[..., OFF_SWA_Q:OFF_SWA_K].reshape(B, S, SWA_HEADS, SWA_HEAD_DIM)
        k_a = proj[..., OFF_SWA_K:OFF_SWA_V].reshape(B, S, SWA_KV_HEADS, SWA_HEAD_DIM)
        v_a = proj[..., OFF_SWA_V:OFF_MLA_CQ].reshape(B, S, SWA_KV_HEADS, SWA_HEAD_DIM)
        o_a = swa_sink_attention(q_a, k_a, v_a, swa_sinks[l], rel_bias)

        c_q = rmsnorm(proj[..., OFF_MLA_CQ:OFF_MLA_CKV], mla_q_norm_g[l])
        c_kv = rmsnorm(proj[..., OFF_MLA_CKV:OFF_MLA_KR], mla_kv_norm_g[l])
        k_rope = rope(proj[..., OFF_MLA_KR:IN_COLS], positions)
        q_b = jnp.einsum('bsr,rf->bsf', c_q, w_uq[l]).reshape(B, S, MLA_HEADS, MLA_QK_DIM)
        q_nope = q_b[..., :MLA_NOPE_DIM]
        q_rope = rope(q_b[..., MLA_NOPE_DIM:], positions)
        kv_b = jnp.einsum('bsr,rf->bsf', c_kv, w_ukv[l]).reshape(B, S, MLA_HEADS, MLA_NOPE_DIM + MLA_V_DIM)
        k_nope = kv_b[..., :MLA_NOPE_DIM]
        v_b = kv_b[..., MLA_NOPE_DIM:]
        o_b = mla_attention(q_nope, q_rope, k_nope, k_rope, v_b)

        mix = jnp.concatenate([o_a, o_b], axis=-1)
        x = x + g1 * jnp.einsum('bsm,md->bsd', mix, w_out[l])

        h = rmsnorm(x, mlp_norm_g[l]) * (1.0 + sc2) + sh2
        u = jax.nn.relu(jnp.einsum('bsd,df->bsf', h, w_ff1[l]))
        x = x + g2 * jnp.einsum('bsf,fd->bsd', u * u, w_ff2[l])
    return rmsnorm(x, final_norm_g)
```

```cpp
#include <hip/hip_runtime.h>
#include <cstdio>
#include <cstdint>

#ifndef MK_N_LAUNCHES
#define MK_N_LAUNCHES 1
#endif
#ifndef NAIVE_GEMM
#define NAIVE_GEMM 0
#endif
#ifndef NAIVE_ATTN
#define NAIVE_ATTN 1
#endif

constexpr int NB = 4, SEQ = 4096, DM = 2048, M = NB * SEQ, FF = 8192;
constexpr int IN_COLS = 1856, IN_PAD = 2048;
constexpr int QRANK = 384, KVRANK = 128, NQB = 1536, NKVB = 2048;
constexpr float EPS = 1e-6f;
constexpr float LOG2E = 1.4426950408889634f;
constexpr float CA = 0.125f * LOG2E;
constexpr float C2M = 0.07216878364870322f * LOG2E;
constexpr int OFF_KA = 1024, OFF_VA = 1152, OFF_CQ = 1280, OFF_CKV = 1664, OFF_KR = 1792;

namespace pg8 {
#define PG8_LAS __attribute__((address_space(3)))
typedef unsigned short bf16_t;
typedef short bf16x8 __attribute__((ext_vector_type(8)));
typedef float f32x4 __attribute__((ext_vector_type(4)));
typedef unsigned u32x4 __attribute__((ext_vector_type(4)));
constexpr int BM = 256, BK = 64, HALF = 128, HTB = HALF * BK * 2, STAGE_BYTES = 8 * HTB, NXCD = 8, WGM = 8;

__host__ __device__ __forceinline__ int lds_byte(int r, int c) { const int st = (r >> 4) * 2 + (c >> 5), rr = r & 15, cc = c & 31, ob = rr * 64 + cc * 2; return st * 1024 + (ob ^ (((ob >> 9) & 1) << 5)); }
__host__ __device__ __forceinline__ void stage_rc(int b, int& R, int& C) { const int st = b / 1024, sb = b % 1024, swz = sb ^ (((sb >> 9) & 1) << 5); R = (st >> 1) * 16 + swz / 64; C = (st & 1) * 32 + (swz % 64) / 2; }
__host__ __device__ __forceinline__ int perm32(int rho) { const int n = rho >> 4, i = rho & 15; return 8 * (i >> 2) + 4 * n + (i & 3); }

struct Unit { int pm, pn; };
struct Gemm { const bf16_t* A; const bf16_t* Bt; int M, N, K; };

struct StaticOrder {
    int nM, nN, nwg, G, c;
    __host__ __device__ void init(int M_, int N_, int G_, int c_) { nM = M_ / BM; nN = N_ / BM; nwg = nM * nN; G = G_; c = c_; }
    __host__ __device__ bool next(int i, Unit& u) const {
        const long L = (long)i * G + c; if (L >= nwg) return false;
        int wgid = (int)L; { const int q = nwg / NXCD, r = nwg % NXCD, xcd = wgid % NXCD, off = wgid / NXCD; wgid = (xcd < r ? xcd * (q + 1) : r * (q + 1) + (xcd - r) * q) + off; }
        const int nig = WGM * nN, gid = wgid / nig, fm = gid * WGM, gsz = (nM - fm) < WGM ? (nM - fm) : WGM;
        u.pm = fm + ((wgid % nig) % gsz); u.pn = (wgid % nig) / gsz; return true;
    }
    __device__ __forceinline__ void a_ready(const Unit&) const {}
    __device__ __forceinline__ void done(const Unit&) const {}
};

__device__ __forceinline__ unsigned cvt_pk_bf16(float lo, float hi) { unsigned r; asm volatile("v_cvt_pk_bf16_f32 %0, %1, %2" : "=v"(r) : "v"(lo), "v"(hi)); return r; }

template <class F> struct EpiRow {
    static constexpr bool PERM = false, AFTER_DRAIN = false;
    F f;
    __device__ __forceinline__ void operator()(const f32x4 (&acc)[2][2][4][2], const Unit& u, int wr, int wc, int fr, int fq) const {
        asm volatile("" : "+v"(fr), "+v"(fq));
        const int colb = u.pn * BM + wc * 32 + 4 * fq;
        const bool slots = f.tile_has_slots(u.pn * BM);
#pragma unroll
        for (int ai = 0; ai < 2; ++ai)
#pragma unroll
            for (int m = 0; m < 4; ++m) {
                const int row = u.pm * BM + ai * HALF + wr * 64 + m * 16 + fr;
                const auto rc = f.row_ctx(row);
#pragma unroll
                for (int bj = 0; bj < 2; ++bj) {
#pragma unroll
                    for (int n = 0; n < 2; ++n) f(rc, row, colb + bj * HALF + n * 16, acc[ai][bj][m][n]);
                    if constexpr (F::HAS_SLOTS) {
                        if (slots) {
                            const f32x4 a = acc[ai][bj][m][0], b = acc[ai][bj][m][1];
                            float s = (a[0] * a[0] + a[1] * a[1]) + (a[2] * a[2] + a[3] * a[3]) + (b[0] * b[0] + b[1] * b[1]) + (b[2] * b[2] + b[3] * b[3]);
                            s += __shfl_xor(s, 16); s += __shfl_xor(s, 32);
                            if (fq == 0) f.slot_store(row, u.pn * BM + bj * HALF + wc * 32, s);
                        }
                    }
                }
                asm volatile("" ::: "memory");
            }
    }
};

template <class Epi, class Sched, bool ALIGN_EPI = false, bool SP2 = false>
__device__ __forceinline__ void gemm_phase(PG8_LAS unsigned char* lds, const Gemm g, const Sched& S, const Epi& E) {
    const int tid = threadIdx.x, wid = __builtin_amdgcn_readfirstlane(tid >> 6), lane = tid & 63, wr = wid >> 2, wc = wid & 3, fr = lane & 15, fq = lane >> 4;
    const int K = g.K, nt = K / BK;
    unsigned voffA[2], voffB[2];
#pragma unroll
    for (int i = 0; i < 2; ++i) { int R, C; stage_rc(tid * 16 + i * 8192, R, C); const int Rb = Epi::PERM ? ((R & ~31) + perm32(R & 31)) : R;
        voffA[i] = (unsigned)(R * K + C) * 2u; voffB[i] = (unsigned)(Rb * K + C) * 2u; }
    const size_t kstep = (size_t)(BK * 2);
    const size_t hstep = (size_t)HALF * K * 2;
    const size_t tstep = 2 * hstep;
    const unsigned ldsw = (unsigned)wid * 1024u;
    const int aoff = lds_byte(wr * 64 + fr, fq * 8), boff = lds_byte(wc * 32 + fr, fq * 8);
#define PG8_SA(b, h) (((b) * 2 + (h)) * HTB)
#define PG8_SB(b, h) ((4 + (b) * 2 + (h)) * HTB)
#define PG8_STAGE(bufoff, gbase, voff) do { _Pragma("unroll") for (int _i = 0; _i < 2; ++_i) \
        __builtin_amdgcn_global_load_lds((const unsigned*)((const char*)(gbase) + (voff)[_i]), (PG8_LAS unsigned*)(lds + (bufoff) + ldsw + _i * 8192), 16, 0, 0); } while (0)
#define PG8_LDA(dst, b, h) do { _Pragma("unroll") for (int m = 0; m < 4; ++m) _Pragma("unroll") for (int k = 0; k < 2; ++k) dst[m][k] = *(const PG8_LAS bf16x8*)(lds + PG8_SA(b, h) + aoff + m * 2048 + k * 1024); } while (0)
#define PG8_LDB(dst, b, h) do { _Pragma("unroll") for (int n = 0; n < 2; ++n) _Pragma("unroll") for (int k = 0; k < 2; ++k) dst[n][k] = *(const PG8_LAS bf16x8*)(lds + PG8_SB(b, h) + boff + n * 2048 + k * 1024); } while (0)
#define PG8_MMA(ai, bj, At, Bt) do { __builtin_amdgcn_s_setprio(1); _Pragma("unroll") for (int m = 0; m < 4; ++m) _Pragma("unroll") for (int n = 0; n < 2; ++n) _Pragma("unroll") for (int k = 0; k < 2; ++k) \
        acc[ai][bj][m][n] = __builtin_amdgcn_mfma_f32_16x16x32_bf16(Bt[n][k], At[m][k], acc[ai][bj][m][n], 0, 0, 0); __builtin_amdgcn_s_setprio(0); } while (0)
#define PG8_WAIT_V(n) asm volatile("s_waitcnt vmcnt(" #n ")" ::: "memory")
#define PG8_WAIT_L(n) asm volatile("s_waitcnt lgkmcnt(" #n ")" ::: "memory")
#define PG8_BAR __builtin_amdgcn_s_barrier()
#define PG8_SCHED __builtin_amdgcn_sched_barrier(0)
    Unit cur, nxt; int ui = 0;
    if (!S.next(0, cur)) return;
    f32x4 acc[2][2][4][2];
#pragma unroll
    for (int a = 0; a < 2; ++a)
#pragma unroll
        for (int b = 0; b < 2; ++b)
#pragma unroll
            for (int m = 0; m < 4; ++m)
#pragma unroll
                for (int n = 0; n < 2; ++n) acc[a][b][m][n] = (f32x4){0.f, 0.f, 0.f, 0.f};
    bf16x8 At[4][2], B0[2][2], B1[2][2];
    const char* cA = (const char*)g.A + (size_t)cur.pm * tstep; const char* cB = (const char*)g.Bt + (size_t)cur.pn * tstep;
    S.a_ready(cur);
    if constexpr (SP2) {
        PG8_STAGE(PG8_SB(0, 0), cB, voffB); PG8_STAGE(PG8_SB(0, 1), cB + hstep, voffB); PG8_STAGE(PG8_SA(0, 0), cA, voffA); PG8_STAGE(PG8_SA(0, 1), cA + hstep, voffA);
        if (wr == 1) PG8_BAR;
        PG8_WAIT_V(2); PG8_BAR;
        PG8_STAGE(PG8_SB(1, 0), cB + kstep, voffB); PG8_STAGE(PG8_SA(1, 0), cA + kstep, voffA); PG8_STAGE(PG8_SB(1, 1), cB + hstep + kstep, voffB);
        PG8_WAIT_V(6); PG8_BAR;
    } else {
        PG8_STAGE(PG8_SB(0, 0), cB, voffB); PG8_STAGE(PG8_SA(0, 0), cA, voffA); PG8_STAGE(PG8_SB(0, 1), cB + hstep, voffB); PG8_STAGE(PG8_SA(0, 1), cA + hstep, voffA);
        if (wr == 1) PG8_BAR;
        PG8_WAIT_V(4); PG8_BAR;
        PG8_STAGE(PG8_SB(1, 0), cB + kstep, voffB); PG8_STAGE(PG8_SA(1, 0), cA + kstep, voffA); PG8_STAGE(PG8_SB(1, 1), cB + hstep + kstep, voffB);
        PG8_WAIT_V(6); PG8_BAR;
    }
    for (;;) {
        const bool has_next = S.next(ui + 1, nxt);
        const char* nA = has_next ? (const char*)g.A + (size_t)nxt.pm * tstep : cA; const char* nB = has_next ? (const char*)g.Bt + (size_t)nxt.pn * tstep : cB;
        for (int t = 0; t < nt; t += 2) {
            const bool last = (t == nt - 2);
            const char* a1 = cA + (size_t)(t + 1) * kstep;
            const char* a2 = last ? nA : cA + (size_t)(t + 2) * kstep; const char* b2 = last ? nB : cB + (size_t)(t + 2) * kstep;
            const char* a3 = a2 + kstep; const char* b3 = b2 + kstep;
            if (last && has_next) S.a_ready(nxt);
            if constexpr (SP2) {
            PG8_LDB(B0, 0, 0); PG8_LDB(B1, 0, 1); PG8_SCHED; PG8_LDA(At, 0, 0); PG8_STAGE(PG8_SA(1, 1), a1 + hstep, voffA);
            PG8_WAIT_V(8); PG8_WAIT_L(0); PG8_BAR; PG8_MMA(0, 0, At, B0); PG8_MMA(0, 1, At, B1); PG8_BAR; PG8_SCHED;
            PG8_LDA(At, 0, 1); PG8_STAGE(PG8_SB(0, 0), b2, voffB); PG8_STAGE(PG8_SB(0, 1), b2 + hstep, voffB); PG8_STAGE(PG8_SA(0, 0), a2, voffA);
            PG8_WAIT_V(8); PG8_WAIT_L(0); PG8_BAR; PG8_MMA(1, 0, At, B0); PG8_MMA(1, 1, At, B1); PG8_BAR; PG8_SCHED;
            PG8_LDB(B0, 1, 0); PG8_LDB(B1, 1, 1); PG8_SCHED; PG8_LDA(At, 1, 0); PG8_STAGE(PG8_SA(0, 1), a2 + hstep, voffA);
            PG8_WAIT_V(8); PG8_WAIT_L(0); PG8_BAR; PG8_MMA(0, 0, At, B0); PG8_MMA(0, 1, At, B1); PG8_BAR; PG8_SCHED;
            PG8_LDA(At, 1, 1); PG8_STAGE(PG8_SB(1, 0), b3, voffB); PG8_STAGE(PG8_SB(1, 1), b3 + hstep, voffB); PG8_STAGE(PG8_SA(1, 0), a3, voffA);
            PG8_WAIT_V(8); PG8_WAIT_L(0); PG8_BAR; PG8_MMA(1, 0, At, B0); PG8_MMA(1, 1, At, B1); PG8_BAR; PG8_SCHED;
            } else {
            PG8_LDB(B0, 0, 0); PG8_SCHED; PG8_LDA(At, 0, 0); PG8_STAGE(PG8_SA(1, 1), a1 + hstep, voffA);
            PG8_WAIT_L(8); PG8_BAR; PG8_WAIT_L(0); PG8_MMA(0, 0, At, B0); PG8_BAR; PG8_SCHED;
            PG8_LDB(B1, 0, 1); PG8_STAGE(PG8_SB(0, 0), b2, voffB);
            PG8_BAR; PG8_WAIT_L(0); PG8_MMA(0, 1, At, B1); PG8_BAR;
            PG8_LDA(At, 0, 1); PG8_STAGE(PG8_SA(0, 0), a2, voffA);
            PG8_BAR; PG8_WAIT_L(0); PG8_MMA(1, 0, At, B0); PG8_BAR; PG8_SCHED;
            PG8_STAGE(PG8_SB(0, 1), b2 + hstep, voffB);
            PG8_WAIT_V(6); PG8_BAR; PG8_MMA(1, 1, At, B1); PG8_BAR;
            PG8_LDB(B0, 1, 0); PG8_SCHED; PG8_LDA(At, 1, 0); PG8_STAGE(PG8_SA(0, 1), a2 + hstep, voffA);
            PG8_WAIT_L(8); PG8_BAR; PG8_WAIT_L(0); PG8_MMA(0, 0, At, B0); PG8_BAR; PG8_SCHED;
            PG8_LDB(B1, 1, 1); PG8_STAGE(PG8_SB(1, 0), b3, voffB);
            PG8_BAR; PG8_WAIT_L(0); PG8_MMA(0, 1, At, B1); PG8_BAR;
            PG8_LDA(At, 1, 1); PG8_STAGE(PG8_SA(1, 0), a3, voffA);
            PG8_BAR; PG8_WAIT_L(0); PG8_MMA(1, 0, At, B0); PG8_BAR; PG8_SCHED;
            PG8_STAGE(PG8_SB(1, 1), b3 + hstep, voffB);
            PG8_WAIT_V(6); PG8_BAR; PG8_MMA(1, 1, At, B1); PG8_BAR;
            }
        }
        if constexpr (ALIGN_EPI) { if (wr == 0) PG8_BAR; }
        if constexpr (!Epi::AFTER_DRAIN) { E(acc, cur, wr, wc, fr, fq); S.done(cur); }
        if (!has_next) break;
#pragma unroll
        for (int a = 0; a < 2; ++a)
#pragma unroll
            for (int b = 0; b < 2; ++b)
#pragma unroll
                for (int m = 0; m < 4; ++m)
#pragma unroll
                    for (int n = 0; n < 2; ++n) acc[a][b][m][n] = (f32x4){0.f, 0.f, 0.f, 0.f};
        cur = nxt; cA = nA; cB = nB; ++ui;
        if constexpr (ALIGN_EPI) { if (wr == 1) PG8_BAR; }
    }
    PG8_WAIT_V(0);
    if constexpr (!ALIGN_EPI) { if (wr == 0) PG8_BAR; }
    PG8_BAR;
#undef PG8_SA
#undef PG8_SB
#undef PG8_STAGE
#undef PG8_LDA
#undef PG8_LDB
#undef PG8_MMA
#undef PG8_WAIT_V
#undef PG8_WAIT_L
#undef PG8_BAR
#undef PG8_SCHED
}
}

#ifndef PG8_SP2
#define PG8_SP2 true
#endif
#ifndef PG8_ALIGN
#define PG8_ALIGN true
#endif

constexpr int NWAVES = 8;
constexpr int N_LAUNCHES = MK_N_LAUNCHES;
constexpr int PER_PHASE = 10;

constexpr size_t MiB = 1u << 20;
constexpr size_t WS_CTL = 0, CTL_ZERO_BYTES = 2 * MiB;
constexpr size_t WS_SSQ = 1 * MiB;
constexpr size_t WS_MOD = 2 * MiB;
constexpr size_t WS_BIAS = 2 * MiB + 512 * 1024;
constexpr size_t WS_ROPE = 3 * MiB;
constexpr size_t WS_PART = 4 * MiB;
constexpr size_t WS_WIN = 8 * MiB;
constexpr size_t WS_WUQ = 16 * MiB;
constexpr size_t WS_WUKV = 18 * MiB;
constexpr size_t WS_WOUT = 20 * MiB;
constexpr size_t WS_W1 = 28 * MiB;
constexpr size_t WS_W2 = 60 * MiB;
constexpr size_t WS_H = 92 * MiB;
constexpr size_t WS_QA = 92 * MiB;
constexpr size_t WS_KA = 124 * MiB;
constexpr size_t WS_VA = 128 * MiB;
constexpr size_t WS_CQ = 132 * MiB;
constexpr size_t WS_CKV = 144 * MiB;
constexpr size_t WS_KR = 148 * MiB;
constexpr size_t WS_QB = 150 * MiB;
constexpr size_t WS_KN = 198 * MiB;
constexpr size_t WS_VB = 230 * MiB;
constexpr size_t WS_MIX = 262 * MiB;
constexpr size_t WS_XN = 348 * MiB;
constexpr size_t WS_END = 412 * MiB;
static_assert(WS_MIX + (size_t)M * DM * 2 <= WS_H + (size_t)M * FF * 2 && WS_H + (size_t)M * FF * 2 <= WS_XN && WS_XN + (size_t)M * DM * 2 <= WS_END, "d_ws map");
constexpr int CW_TMO = 0, CW_CODE = 1;
constexpr int CW_BAR = 4096;

constexpr int RING_OFF = 0, RING_BYTES = 131072;
constexpr int LDSCTL_OFF = RING_BYTES, MISC_OFF = LDSCTL_OFF + 320;
constexpr int LDS_EXTRA_OFF = 132 * 1024;
constexpr int LDS_BYTES = 147456;

#define GAS __attribute__((address_space(1)))
#define LAS __attribute__((address_space(3)))
typedef unsigned short bf16;
typedef unsigned v4u __attribute__((ext_vector_type(4)));
typedef unsigned v2u __attribute__((ext_vector_type(2)));
typedef float f32x4 __attribute__((ext_vector_type(4)));
typedef float f32x2 __attribute__((ext_vector_type(2)));
typedef short bf16x8 __attribute__((ext_vector_type(8)));
typedef GAS unsigned gu32;
#define RLX_AGENT __ATOMIC_RELAXED, __HIP_MEMORY_SCOPE_AGENT
#define LDS_WAIT() asm volatile("s_waitcnt lgkmcnt(0)" ::: "memory")
#define VM_WAIT() asm volatile("s_waitcnt vmcnt(0)" ::: "memory")
__device__ __forceinline__ unsigned f2bf(float f) { unsigned u = __builtin_bit_cast(unsigned, f); return (u + 0x7fffu + ((u >> 16) & 1u)) >> 16; }
__device__ __forceinline__ unsigned pk2(float lo, float hi) { return f2bf(lo) | (f2bf(hi) << 16); }
__device__ __forceinline__ float bf2f(unsigned h) { return __builtin_bit_cast(float, h << 16); }

#define XB_TMO      128
#define XB_XCNT(j)  (256  + 64 * (j))
#define XB_XSUB(j)  (1280 + 64 * (j))
#define XB_XGEN(j)  (2304 + 64 * (j))
#define XB_TOP      3328
#define XB_TOPGEN   3392
#define XCD_BAR_WORDS 3456
#define XB_SPIN_CAP (1u << 18)
__device__ __forceinline__ unsigned xb_ld(unsigned* p)              { return __hip_atomic_load(p, __ATOMIC_RELAXED, __HIP_MEMORY_SCOPE_AGENT); }
__device__ __forceinline__ unsigned xb_add(unsigned* p, unsigned v) { return __hip_atomic_fetch_add(p, v, __ATOMIC_RELAXED, __HIP_MEMORY_SCOPE_AGENT); }
__device__ __forceinline__ unsigned xb_xcc_id() { return (unsigned)__builtin_amdgcn_s_getreg((3 << 11) | 20) & 0xFu; }
#define XB_SPIN(cond, bar) do { unsigned _sp = 0; while (cond) { __builtin_amdgcn_s_sleep(1); \
    if ((++_sp & 255u) == 0u) { if (xb_ld(&(bar)[XB_TMO])) break; if (_sp > XB_SPIN_CAP) { atomicAdd(&(bar)[XB_TMO], 1u); break; } } } } while (0)
struct XcdBarrier { unsigned* bar; unsigned x; volatile LAS unsigned* st; };
__device__ __forceinline__ XcdBarrier xcd_barrier_post(unsigned* bar, volatile LAS unsigned* st) {
    XcdBarrier b; b.bar = bar; b.x = xb_xcc_id(); b.st = st;
    if (threadIdx.x == 0) (void)xb_add(&bar[XB_XCNT(b.x)], 1u);
    return b;
}
__device__ __forceinline__ void xcd_barrier_complete(unsigned* bar, unsigned x, unsigned& nloc, unsigned& nx) {
    const unsigned G = gridDim.x * gridDim.y * gridDim.z;
    unsigned sum, cnt, mine, sp = 0u;
    for (;;) {
        sum = 0u; cnt = 0u; mine = 0u;
#pragma unroll
        for (unsigned j = 0; j < 16; ++j) { const unsigned c = xb_ld(&bar[XB_XCNT(j)]); sum += c; cnt += (c > 0u) ? 1u : 0u; mine = (j == x) ? c : mine; }
        if (sum == G) break;
        __builtin_amdgcn_s_sleep(1);
        if ((++sp & 255u) == 0u) { if (xb_ld(&bar[XB_TMO])) break; if (sp > XB_SPIN_CAP) { atomicAdd(&bar[XB_TMO], 1u); break; } }
    }
    nloc = mine > 0u ? mine : 1u; nx = cnt > 0u ? cnt : 1u;
}
__device__ __forceinline__ void xcd_barrier(const XcdBarrier& b) {
    asm volatile("s_waitcnt vmcnt(0)" ::: "memory");
    __syncthreads();
    if (threadIdx.x == 0) {
        unsigned* bar = b.bar;
        __builtin_amdgcn_s_waitcnt(0);
        unsigned nloc = b.st[0], nx = b.st[1];
        if (nloc == 0u) { xcd_barrier_complete(bar, b.x, nloc, nx); b.st[0] = nloc; b.st[1] = nx; }
        const unsigned old = xb_add(&bar[XB_XSUB(b.x)], 1u);
        const unsigned gen = old / nloc;
        if (old + 1u == (gen + 1u) * nloc) {
            __builtin_amdgcn_fence(__ATOMIC_RELEASE, "agent");
            asm volatile("s_waitcnt vmcnt(0)" ::: "memory");
            const unsigned og = xb_add(&bar[XB_TOP], 1u);
            const unsigned tg = og / nx;
            if (og + 1u == (tg + 1u) * nx) xb_add(&bar[XB_TOPGEN], 1u);
            else XB_SPIN(xb_ld(&bar[XB_TOPGEN]) == tg, bar);
            __builtin_amdgcn_fence(__ATOMIC_ACQUIRE, "agent");
            xb_add(&bar[XB_XGEN(b.x)], 1u);
            asm volatile("s_waitcnt vmcnt(0)" ::: "memory");
        } else {
            XB_SPIN(xb_ld(&bar[XB_XGEN(b.x)]) == gen, bar);
            __builtin_amdgcn_fence(__ATOMIC_ACQUIRE, "agent");
            asm volatile("s_waitcnt vmcnt(0)" ::: "memory");
        }
    }
    __syncthreads();
}

struct Frame {
    LAS unsigned char* lds;
    volatile LAS unsigned* MISC;
    gu32* ctl;
    int tid, lane, wave;
    int vcu, G;
    unsigned char* ws; float* out;
};
constexpr int INPTR_OFF = LDSCTL_OFF + 512;
__device__ __forceinline__ const float* in_ptr(const Frame& F, int k) {
    const unsigned long long v = ((const LAS unsigned long long*)(F.lds + INPTR_OFF))[k];
    const unsigned lo = __builtin_amdgcn_readfirstlane((unsigned)v), hi = __builtin_amdgcn_readfirstlane((unsigned)(v >> 32));
    return (const float*)(((unsigned long long)hi << 32) | lo);
}
#define WSP(T, off) ((T*)(F.ws + (off)))


__device__ __forceinline__ float wave_sum(float v) {
#pragma unroll
    for (int o = 1; o < 64; o <<= 1) v += __shfl_xor(v, o);
    return v;
}
__device__ __forceinline__ float wave_max(float v) {
#pragma unroll
    for (int o = 1; o < 64; o <<= 1) v = fmaxf(v, __shfl_xor(v, o));
    return v;
}

__device__ __forceinline__ int t5_bucket(int n) {
    if (n < 16) return n;
    const unsigned char T[112] = {16,16,16,17,17,18,18,18,19,19,19,20,20,20,20,21,21,21,21,22,22,22,22,22,23,23,23,23,23,23,24,24,24,24,24,24,25,25,25,25,25,25,25,26,26,26,26,26,26,26,26,27,27,27,27,27,27,27,27,27,27,28,28,28,28,28,28,28,28,28,28,29,29,29,29,29,29,29,29,29,29,29,29,30,30,30,30,30,30,30,30,30,30,30,30,30,30,31,31,31,31,31,31,31,31,31,31,31,31,31,31,31};
    return T[n - 16];
}

__device__ __forceinline__ void sincos_acc(float ang, float& s_out, float& c_out) {
    const double x = (double)ang;
    const double k = __builtin_rint(x * 0.15915494309189535);
    double r = __builtin_fma(-k, 6.283185307179586, x); r = __builtin_fma(-k, 2.4492935982947064e-16, r);
    const double y = r * 0.25, y2 = y * y;
    double s = y * (1.0 + y2 * (-1.0 / 6 + y2 * (1.0 / 120 + y2 * (-1.0 / 5040 + y2 * (1.0 / 362880 + y2 * (-1.0 / 39916800 + y2 * (1.0 / 6227020800.0)))))));
    double c = 1.0 + y2 * (-0.5 + y2 * (1.0 / 24 + y2 * (-1.0 / 720 + y2 * (1.0 / 40320 + y2 * (-1.0 / 3628800 + y2 * (1.0 / 479001600.0))))));
    double s2 = 2.0 * s * c, c2 = 1.0 - 2.0 * s * s;
    double s4 = 2.0 * s2 * c2, c4 = 1.0 - 2.0 * s2 * s2;
    s_out = (float)s4; c_out = (float)c4;
}

template <int MODE> __device__ __forceinline__ int dst_row(int n) {
    if (MODE == 1) { if (n >= OFF_KR) { const int j = n - OFF_KR; return OFF_KR + 2 * (j & 31) + (j >> 5); } return n; }
    if (MODE == 2) { const int h = n / 192, w = n - h * 192; if (w >= 128) { const int j = w - 128; return h * 192 + 128 + 2 * (j & 31) + (j >> 5); } return n; }
    return n;
}
template <int MODE> __device__ __forceinline__ void p0_transpose_item(const float* W, int K, int N, bf16* WT, LAS float* scr, int item, int lane, const float* gs) {
    const int nblk = N / 32, kb = item / nblk, nb = item % nblk, k0 = 64 * kb, n0 = 32 * nb;
#pragma unroll 8
    for (int i = 0; i < 32; ++i) { const int kk = 2 * i + (lane >> 5); scr[kk * 33 + (lane & 31)] = W[(size_t)(k0 + kk) * N + n0 + (lane & 31)]; }
    LDS_WAIT(); asm volatile("" ::: "memory");
    const int c = lane & 7;
    float g[8];
#pragma unroll
    for (int e = 0; e < 8; ++e) g[e] = gs ? gs[k0 + 8 * c + e] : 1.0f;
#pragma unroll
    for (int j = 0; j < 4; ++j) { const int n = (lane >> 3) + 8 * j; const LAS float* s = scr + (8 * c) * 33 + n;
        v4u o; o.x = pk2(s[0 * 33] * g[0], s[1 * 33] * g[1]); o.y = pk2(s[2 * 33] * g[2], s[3 * 33] * g[3]); o.z = pk2(s[4 * 33] * g[4], s[5 * 33] * g[5]); o.w = pk2(s[6 * 33] * g[6], s[7 * 33] * g[7]);
        *(GAS v4u*)(WT + (size_t)dst_row<MODE>(n0 + n) * K + k0 + 8 * c) = o; }
    LDS_WAIT(); asm volatile("" ::: "memory");
}
constexpr int MOD_KS = 16, MOD_N = 6 * DM, MOD_CG = MOD_N / 256;
__device__ __forceinline__ void p0_prologue(Frame& F) {
    LAS float* sil = (LAS float*)(F.lds + RING_OFF);
    LAS float* scr = (LAS float*)(F.lds + RING_OFF + 32768 + F.wave * 8704);
    for (int i = F.tid; i < NB * DM; i += NWAVES * 64) { const float v = in_ptr(F, 1)[i]; sil[i] = v / (1.0f + __expf(-v)); }
    __syncthreads();
    const int gw = F.vcu * NWAVES + F.wave, NGW = F.G * NWAVES, lane = F.lane;
    constexpr int T_MOD = MOD_KS * MOD_CG;
    constexpr int I_IN = (DM / 64) * (IN_COLS / 32), I_UQ = (QRANK / 64) * (NQB / 32), I_UKV = (KVRANK / 64) * (NKVB / 32), I_OUT = (DM / 64) * (DM / 32), I_1 = (DM / 64) * (FF / 32), I_2 = (FF / 64) * (DM / 32);
    constexpr int T_PAD = IN_PAD - IN_COLS, T_ROPE = SEQ * 32 / 64, T_BIAS = 16 * 128 / 64;
    constexpr int NT = T_MOD + I_IN + I_UQ + I_UKV + I_OUT + I_1 + I_2 + T_PAD + T_ROPE + T_BIAS;
    for (int it = gw; it < NT; it += NGW) {
        int r = it;
        if (r < T_MOD) {
            const int cg = r % MOD_CG, ks = r / MOD_CG, j0 = cg * 256 + 4 * lane, k0 = ks * (DM / MOD_KS);
            f32x4 acc[4] = {{0.f, 0.f, 0.f, 0.f}, {0.f, 0.f, 0.f, 0.f}, {0.f, 0.f, 0.f, 0.f}, {0.f, 0.f, 0.f, 0.f}};
            for (int kk = 0; kk < DM / MOD_KS; kk += 8) {
                f32x4 w[8];
#pragma unroll
                for (int u = 0; u < 8; ++u) w[u] = *(const GAS f32x4*)(in_ptr(F, 2) + (size_t)(k0 + kk + u) * MOD_N + j0);
#pragma unroll
                for (int u = 0; u < 8; ++u)
#pragma unroll
                    for (int b = 0; b < 4; ++b) acc[b] += sil[b * DM + k0 + kk + u] * w[u];
            }
#pragma unroll
            for (int b = 0; b < 4; ++b) *(GAS f32x4*)(WSP(float, WS_PART) + (size_t)(ks * 4 + b) * MOD_N + j0) = acc[b];
            continue;
        }
        r -= T_MOD;
        if (r < I_IN) { p0_transpose_item<1>(in_ptr(F, 5), DM, IN_COLS, WSP(bf16, WS_WIN), scr, r, lane, nullptr); continue; } r -= I_IN;
        if (r < I_UQ) { p0_transpose_item<2>(in_ptr(F, 9), QRANK, NQB, WSP(bf16, WS_WUQ), scr, r, lane, in_ptr(F, 8)); continue; } r -= I_UQ;
        if (r < I_UKV) { p0_transpose_item<0>(in_ptr(F, 11), KVRANK, NKVB, WSP(bf16, WS_WUKV), scr, r, lane, in_ptr(F, 10)); continue; } r -= I_UKV;
        if (r < I_OUT) { p0_transpose_item<0>(in_ptr(F, 12), DM, DM, WSP(bf16, WS_WOUT), scr, r, lane, nullptr); continue; } r -= I_OUT;
        if (r < I_1) { p0_transpose_item<0>(in_ptr(F, 14), DM, FF, WSP(bf16, WS_W1), scr, r, lane, nullptr); continue; } r -= I_1;
        if (r < I_2) { p0_transpose_item<0>(in_ptr(F, 15), FF, DM, WSP(bf16, WS_W2), scr, r, lane, nullptr); continue; } r -= I_2;
        if (r < T_PAD) {
            GAS v4u* o = (GAS v4u*)(WSP(bf16, WS_WIN) + (size_t)(IN_COLS + r) * DM) + lane;
#pragma unroll
            for (int j = 0; j < 4; ++j) o[64 * j] = (v4u){0u, 0u, 0u, 0u};
            continue;
        }
        r -= T_PAD;
        if (r < T_ROPE) {
            const int pos = 2 * r + (lane >> 5), i = lane & 31;
            double f = 1.0; for (int e = 0; e < i; ++e) f *= 0.7498942093324559;
            const float ang = (float)pos * (float)f;
            float s, c; sincos_acc(ang, s, c);
            *(GAS f32x2*)(WSP(float, WS_ROPE) + ((size_t)pos * 32 + i) * 2) = (f32x2){c, s};
            continue;
        }
        r -= T_ROPE;
        { const int e = r * 64 + lane, head = e >> 7, dist = e & 127;
          WSP(float, WS_BIAS)[e] = in_ptr(F, 7)[t5_bucket(dist) * 16 + head] * LOG2E; }
    }
}

template <bool FROM_PART> __device__ __forceinline__ void norm_mod_phase(Frame& F, const float* xin, const float* gvec, int sh_chunk, int sc_chunk) {
    LAS f32x2* ab = (LAS f32x2*)(F.lds + RING_OFF);
    const int b = F.vcu / (SEQ / 64);
    for (int k = F.tid; k < DM; k += NWAVES * 64) {
        float sc, sh;
        if (FROM_PART) { sc = in_ptr(F, 3)[sc_chunk * DM + k]; sh = in_ptr(F, 3)[sh_chunk * DM + k];
#pragma unroll 4
            for (int ks = 0; ks < MOD_KS; ++ks) { const float* p = WSP(float, WS_PART) + (size_t)(ks * 4 + b) * MOD_N; sc += p[sc_chunk * DM + k]; sh += p[sh_chunk * DM + k]; } }
        else { sc = WSP(float, WS_MOD)[b * MOD_N + sc_chunk * DM + k]; sh = WSP(float, WS_MOD)[b * MOD_N + sh_chunk * DM + k]; }
        ab[k] = (f32x2){gvec[k] * (1.0f + sc), sh};
    }
    if (FROM_PART) {
        const int o = F.vcu * (NB * MOD_N / 256) + F.tid;
        if (F.tid < NB * MOD_N / 256) { const int bb = o / MOD_N, j = o - bb * MOD_N; float s = in_ptr(F, 3)[j];
            for (int ks = 0; ks < MOD_KS; ++ks) s += WSP(float, WS_PART)[(size_t)(ks * 4 + bb) * MOD_N + j];
            WSP(float, WS_MOD)[o] = s; }
    }
    __syncthreads();
    for (int i = 0; i < 8; ++i) {
        const int row = F.vcu * 64 + F.wave * 8 + i;
        const GAS f32x4* xr = (const GAS f32x4*)(xin + (size_t)row * DM) + F.lane;
        f32x4 v[8]; float s = 0.f;
#pragma unroll
        for (int j = 0; j < 8; ++j) { v[j] = xr[64 * j]; s += (v[j].x * v[j].x + v[j].y * v[j].y) + (v[j].z * v[j].z + v[j].w * v[j].w); }
        const float rstd = 1.0f / sqrtf(wave_sum(s) * (1.0f / DM) + EPS);
        GAS v2u* o8 = (GAS v2u*)(WSP(bf16, WS_XN) + (size_t)row * DM) + F.lane;
#pragma unroll
        for (int j = 0; j < 8; ++j) { const int k = 4 * (F.lane + 64 * j);
            const f32x2 a0 = ab[k], a1 = ab[k + 1], a2 = ab[k + 2], a3 = ab[k + 3];
            o8[64 * j] = (v2u){pk2(v[j].x * rstd * a0.x + a0.y, v[j].y * rstd * a1.x + a1.y), pk2(v[j].z * rstd * a2.x + a2.y, v[j].w * rstd * a3.x + a3.y)}; }
    }
}
__device__ __forceinline__ void final_norm_phase(Frame& F) {
    const int gw = F.vcu * NWAVES + F.wave, NGW = F.G * NWAVES;
    f32x4 g[8];
#pragma unroll
    for (int j = 0; j < 8; ++j) g[j] = *((const GAS f32x4*)in_ptr(F, 16) + F.lane + 64 * j);
    for (int row = gw; row < M; row += NGW) {
        GAS f32x4* xr = (GAS f32x4*)(F.out + (size_t)row * DM) + F.lane;
        f32x4 v[8]; float s = 0.f;
#pragma unroll
        for (int j = 0; j < 8; ++j) { v[j] = xr[64 * j]; s += (v[j].x * v[j].x + v[j].y * v[j].y) + (v[j].z * v[j].z + v[j].w * v[j].w); }
        const float rstd = 1.0f / sqrtf(wave_sum(s) * (1.0f / DM) + EPS);
#pragma unroll
        for (int j = 0; j < 8; ++j) xr[64 * j] = v[j] * rstd * g[j];
    }
}
__device__ __forceinline__ void nan_rows_f32(Frame& F, float* out) {
    const int gw = F.vcu * NWAVES + F.wave, NGW = F.G * NWAVES; const float q = __builtin_nanf("");
    for (int m = gw; m < M; m += NGW) { GAS f32x4* o = (GAS f32x4*)(out + (size_t)m * DM) + F.lane;
#pragma unroll
        for (int j = 0; j < 8; ++j) o[64 * j] = (f32x4){q, q, q, q}; }
}

struct NoCtx {};
__device__ __forceinline__ void st_bf4(bf16* base, unsigned off, f32x4 v) { *(GAS v2u*)(base + off) = (v2u){pk2(v[0], v[1]), pk2(v[2], v[3])}; }
__device__ __forceinline__ f32x4 rope4(const float* ROPE, unsigned pos, unsigned p, f32x4 v) {
    const f32x4 cs = *(const GAS f32x4*)(ROPE + (pos * 64u + p));
    return (f32x4){v[0] * cs[0] - v[1] * cs[1], v[1] * cs[0] + v[0] * cs[1], v[2] * cs[2] - v[3] * cs[3], v[3] * cs[2] + v[2] * cs[3]};
}
template <bool ATOMIC> struct EpiIn {
    static constexpr bool HAS_SLOTS = true;
    bf16 *QA, *KA, *VA, *CQ, *CKV, *KR; float* SSQ; const float* ROPE;
    __device__ __forceinline__ bool tile_has_slots(int col0) const { return !ATOMIC && col0 >= OFF_CQ && col0 < OFF_KR; }
    __device__ __forceinline__ NoCtx row_ctx(int) const { return NoCtx{}; }
    __device__ __forceinline__ void slot_store(int row, int col32, float s) const { if (col32 >= OFF_CQ && col32 < OFF_KR) SSQ[(unsigned)row * 16u + (unsigned)((col32 - OFF_CQ) >> 5)] = s; }
    __device__ __forceinline__ void operator()(NoCtx, int row, int col, f32x4 v) const {
        const int reg = __builtin_amdgcn_readfirstlane(col >> 7);
        const unsigned r = (unsigned)row, c = (unsigned)col;
        if (reg < 8) { st_bf4(QA, r * 1024u + c, v * CA); }
        else if (reg == 8) { st_bf4(KA, r * 128u + (c - OFF_KA), v); }
        else if (reg == 9) { st_bf4(VA, r * 128u + (c - OFF_VA), v); }
        else if (reg < 14) {
            if (reg < 13) st_bf4(CQ, r * QRANK + (c - OFF_CQ), v); else st_bf4(CKV, r * KVRANK + (c - OFF_CKV), v);
            if (ATOMIC) atomicAdd(SSQ + (r * 16u + ((c - OFF_CQ) >> 5)), (v[0] * v[0] + v[1] * v[1]) + (v[2] * v[2] + v[3] * v[3]));
        }
        else if (reg == 14) { if (col < IN_COLS) st_bf4(KR, r * 64u + (c - OFF_KR), rope4(ROPE, r & (SEQ - 1), c - OFF_KR, v)); }
    }
};
struct EpiUp {
    static constexpr bool HAS_SLOTS = false;
    bf16 *QB, *KN, *VB; const float* SSQ; const float* ROPE; int mode;
    __device__ __forceinline__ bool tile_has_slots(int) const { return false; }
    __device__ __forceinline__ void slot_store(int, int, float) const {}
    __device__ __forceinline__ float row_ctx(int row) const {
        const GAS f32x4* s = (const GAS f32x4*)(SSQ + (unsigned)row * 16u);
        if (mode == 0) { const f32x4 a = s[0], b = s[1], c = s[2];
            const float t = ((a[0] + a[1]) + (a[2] + a[3])) + ((b[0] + b[1]) + (b[2] + b[3])) + ((c[0] + c[1]) + (c[2] + c[3]));
            return C2M * __builtin_amdgcn_rsqf(t * (1.0f / QRANK) + EPS); }
        const f32x4 a = s[3];
        return __builtin_amdgcn_rsqf(((a[0] + a[1]) + (a[2] + a[3])) * (1.0f / KVRANK) + EPS);
    }
    __device__ __forceinline__ void operator()(float rs, int row, int col, f32x4 v) const {
        if (mode == 0) {
            const int c32 = __builtin_amdgcn_readfirstlane(col >> 5), h = c32 / 6, w32 = c32 - 6 * h;
            if (w32 >= 4) v = rope4(ROPE, (unsigned)row & (SEQ - 1), (unsigned)(col - h * 192 - 128), v);
            st_bf4(QB, (unsigned)row * NQB + (unsigned)col, v * rs);
        } else {
            const int c128 = __builtin_amdgcn_readfirstlane(col >> 7), h = c128 >> 1;
            const unsigned off = (unsigned)row * 1024u + (unsigned)(h * 128 + (col & 127));
            if ((c128 & 1) == 0) st_bf4(KN, off, v * rs); else st_bf4(VB, off, v * rs);
        }
    }
};
struct EpiRes {
    static constexpr bool HAS_SLOTS = false;
    const float* base; float* out; const float* gate;
    __device__ __forceinline__ bool tile_has_slots(int) const { return false; }
    __device__ __forceinline__ void slot_store(int, int, float) const {}
    __device__ __forceinline__ int row_ctx(int row) const { return __builtin_amdgcn_readfirstlane(row / SEQ); }
    __device__ __forceinline__ void operator()(int b, int row, int col, f32x4 v) const {
        const unsigned off = (unsigned)row * DM + (unsigned)col;
        const f32x4 g = *(const GAS f32x4*)(gate + b * MOD_N + col), x0 = *(const GAS f32x4*)(base + off);
        *(GAS f32x4*)(out + off) = x0 + g * v;
    }
};
struct EpiRelu2 {
    static constexpr bool HAS_SLOTS = false;
    bf16* H;
    __device__ __forceinline__ bool tile_has_slots(int) const { return false; }
    __device__ __forceinline__ void slot_store(int, int, float) const {}
    __device__ __forceinline__ NoCtx row_ctx(int) const { return NoCtx{}; }
    __device__ __forceinline__ void operator()(NoCtx, int row, int col, f32x4 v) const {
        f32x4 u;
#pragma unroll
        for (int e = 0; e < 4; ++e) { const float t = fmaxf(v[e], 0.f); u[e] = t * t; }
        st_bf4(H, (unsigned)row * FF + (unsigned)col, u);
    }
};

template <class Fn> __device__ __forceinline__ void naive_gemm(Frame& F, const bf16* A, const bf16* Bt, int Mr, int N, int K, const Fn& f) {
    const int gw = F.vcu * NWAVES + F.wave, NGW = F.G * NWAVES, fr = F.lane & 15, fq = F.lane >> 4;
    const int tn = N / 32, ntiles = (Mr / 32) * tn;
    for (int t = gw; t < ntiles; t += NGW) {
        const int row0 = (t / tn) * 32, col0 = (t % tn) * 32;
        f32x4 acc[2][2];
#pragma unroll
        for (int a = 0; a < 2; ++a)
#pragma unroll
            for (int b = 0; b < 2; ++b) acc[a][b] = (f32x4){0.f, 0.f, 0.f, 0.f};
        for (int k = 0; k < K; k += 32) {
            bf16x8 a[2], b[2];
#pragma unroll
            for (int i = 0; i < 2; ++i) { a[i] = *(const GAS bf16x8*)(A + (size_t)(row0 + 16 * i + fr) * K + k + 8 * fq); b[i] = *(const GAS bf16x8*)(Bt + (size_t)(col0 + 16 * i + fr) * K + k + 8 * fq); }
#pragma unroll
            for (int mi = 0; mi < 2; ++mi)
#pragma unroll
                for (int ni = 0; ni < 2; ++ni) acc[mi][ni] = __builtin_amdgcn_mfma_f32_16x16x32_bf16(b[ni], a[mi], acc[mi][ni], 0, 0, 0);
        }
#pragma unroll
        for (int mi = 0; mi < 2; ++mi) { const int row = row0 + 16 * mi + fr; const auto rc = f.row_ctx(row);
#pragma unroll
            for (int ni = 0; ni < 2; ++ni) f(rc, row, col0 + 16 * ni + 4 * fq, acc[mi][ni]); }
    }
}

__device__ __forceinline__ void naive_swa(Frame& F) {
    const int gw = F.vcu * NWAVES + F.wave, NGW = F.G * NWAVES, lane = F.lane;
    for (int t = gw; t < NB * 16 * SEQ; t += NGW) {
        const int pos = t % SEQ, head = (t / SEQ) % 16, b = t / (SEQ * 16), hk = head >> 3;
        const size_t row = (size_t)b * SEQ + pos;
        const bf16* q = WSP(bf16, WS_QA) + row * 1024 + head * 64;
        float sc[2];
#pragma unroll
        for (int u = 0; u < 2; ++u) {
            const int kp = pos - 127 + lane + 64 * u; float s = -INFINITY;
            if (kp >= 0) { const bf16* kr = WSP(bf16, WS_KA) + ((size_t)b * SEQ + kp) * 128 + hk * 64; float a = 0.f;
                for (int d = 0; d < 64; d += 8) { const bf16x8 kv = *(const GAS bf16x8*)(kr + d), qv = *(const GAS bf16x8*)(q + d);
#pragma unroll
                    for (int e = 0; e < 8; ++e) a += bf2f((unsigned short)kv[e]) * bf2f((unsigned short)qv[e]); }
                s = a + WSP(float, WS_BIAS)[head * 128 + (pos - kp)]; }
            sc[u] = s;
        }
        const float sink = in_ptr(F, 6)[head] * LOG2E;
        const float m = fmaxf(wave_max(fmaxf(sc[0], sc[1])), sink);
        const float p0 = __builtin_amdgcn_exp2f(sc[0] - m), p1 = __builtin_amdgcn_exp2f(sc[1] - m);
        const float l = wave_sum(p0 + p1) + __builtin_amdgcn_exp2f(sink - m);
        float o = 0.f;
        for (int kk = 0; kk < 128; ++kk) { const float pk = __shfl(kk < 64 ? p0 : p1, kk & 63); const int kp = pos - 127 + kk;
            if (kp >= 0) o += pk * bf2f(WSP(bf16, WS_VA)[((size_t)b * SEQ + kp) * 128 + hk * 64 + lane]); }
        WSP(bf16, WS_MIX)[row * DM + head * 64 + lane] = (bf16)f2bf(o / l);
    }
}
__device__ __forceinline__ void naive_mla(Frame& F) {
    const int gw = F.vcu * NWAVES + F.wave, NGW = F.G * NWAVES, lane = F.lane;
    LAS float* sc = (LAS float*)(F.lds + RING_OFF) + F.wave * 4096;
    LAS float* qf = (LAS float*)(F.lds + LDS_EXTRA_OFF) + F.wave * 192;
    for (int t = gw; t < NB * 8 * (SEQ / 2); t += NGW) {
        const int j = t % (SEQ / 2), bh = t / (SEQ / 2), b = bh >> 3, h = bh & 7;
        for (int pass = 0; pass < 2; ++pass) {
            const int pos = pass ? SEQ - 1 - j : j; const size_t row = (size_t)b * SEQ + pos;
            for (int d = lane; d < 192; d += 64) qf[d] = bf2f(WSP(bf16, WS_QB)[row * NQB + h * 192 + d]);
            LDS_WAIT(); asm volatile("" ::: "memory");
            float mx = -INFINITY;
            for (int kp = lane; kp <= pos; kp += 64) {
                const size_t kr = (size_t)b * SEQ + kp; float a = 0.f;
                for (int d = 0; d < 128; d += 8) { const bf16x8 kv = *(const GAS bf16x8*)(WSP(bf16, WS_KN) + kr * 1024 + h * 128 + d);
#pragma unroll
                    for (int e = 0; e < 8; ++e) a += bf2f((unsigned short)kv[e]) * qf[d + e]; }
                for (int d = 0; d < 64; d += 8) { const bf16x8 kv = *(const GAS bf16x8*)(WSP(bf16, WS_KR) + kr * 64 + d);
#pragma unroll
                    for (int e = 0; e < 8; ++e) a += bf2f((unsigned short)kv[e]) * qf[128 + d + e]; }
                sc[kp] = a; mx = fmaxf(mx, a);
            }
            mx = wave_max(mx);
            float ls = 0.f;
            for (int kp = lane; kp <= pos; kp += 64) { const float p = __builtin_amdgcn_exp2f(sc[kp] - mx); sc[kp] = p; ls += p; }
            ls = wave_sum(ls);
            LDS_WAIT(); asm volatile("" ::: "memory");
            float o0 = 0.f, o1 = 0.f;
            for (int kp = 0; kp <= pos; ++kp) { const float p = sc[kp]; const unsigned vv = *(const GAS unsigned*)(WSP(bf16, WS_VB) + ((size_t)b * SEQ + kp) * 1024 + h * 128 + 2 * lane);
                o0 += p * bf2f(vv & 0xffffu); o1 += p * bf2f(vv >> 16); }
            *(GAS unsigned*)(WSP(bf16, WS_MIX) + row * DM + 1024 + h * 128 + 2 * lane) = pk2(o0 / ls, o1 / ls);
            LDS_WAIT(); asm volatile("" ::: "memory");
        }
    }
}

struct Args { const float* in[17]; float* out; unsigned char* ws; int ph_lo, ph_hi, li, pad; };
__global__ void __launch_bounds__(NWAVES * 64, 2) hymba_fwd(Args args) {
    extern __shared__ __attribute__((aligned(16))) unsigned char lds[];
    Frame F;
    F.lds = (LAS unsigned char*)lds;
    F.MISC = (volatile LAS unsigned*)(F.lds + MISC_OFF);
    F.tid = threadIdx.x; F.lane = F.tid & 63; F.wave = __builtin_amdgcn_readfirstlane(F.tid >> 6);
    F.G = gridDim.x; { const int bx = blockIdx.x; F.vcu = (F.G % 8 == 0) ? (bx % 8) * (F.G / 8) + bx / 8 : bx; }
    unsigned char* ws = args.ws;
    F.ctl = (gu32*)(ws + WS_CTL);
    F.out = args.out; F.ws = ws;
    for (int u = F.tid; u < (LDS_EXTRA_OFF - LDSCTL_OFF) / 4; u += NWAVES * 64) ((LAS unsigned*)(F.lds + LDSCTL_OFF))[u] = 0u;
    __syncthreads();
    if (F.tid == 0) { LAS unsigned long long* t = (LAS unsigned long long*)(F.lds + INPTR_OFF);
#pragma unroll
        for (int k = 0; k < 17; ++k) t[k] = (unsigned long long)(uintptr_t)args.in[k]; }
    __syncthreads();
    XcdBarrier bar; bar.bar = (unsigned*)(F.ctl + CW_BAR); bar.x = 0; bar.st = nullptr;
    if (N_LAUNCHES != PER_PHASE) bar = xcd_barrier_post((unsigned*)(F.ctl + CW_BAR), F.MISC + 8);
#define GRID_BAR(seam) do { if (N_LAUNCHES == PER_PHASE) { if (F.tid == 0) __hip_atomic_store(F.ctl + CW_TMO, 0xBADBA0u | (unsigned)(seam), RLX_AGENT); } else { xcd_barrier(bar); } } while (0)
    const int lo = args.ph_lo, hi = args.ph_hi;
#ifndef ONLY_PHASE
#define ONLY_PHASE -1
#endif
#define IN(k) ((ONLY_PHASE < 0 || ONLY_PHASE == (k)) && lo <= (k) && (k) < hi)
#define BOTH(k) (IN(k) && IN((k) + 1))
    const bool grid_ok = (F.G == 256);

    if (IN(0)) { p0_prologue(F); if (BOTH(0)) GRID_BAR(0); }
    if (IN(1)) { if (grid_ok) norm_mod_phase<true>(F, in_ptr(F, 0), in_ptr(F, 4), 0, 1); __syncthreads(); if (BOTH(1)) GRID_BAR(1); }
    if (IN(2)) {
#if NAIVE_GEMM
        EpiIn<true> f{WSP(bf16, WS_QA), WSP(bf16, WS_KA), WSP(bf16, WS_VA), WSP(bf16, WS_CQ), WSP(bf16, WS_CKV), WSP(bf16, WS_KR), WSP(float, WS_SSQ), WSP(float, WS_ROPE)};
        naive_gemm(F, WSP(bf16, WS_XN), WSP(bf16, WS_WIN), M, IN_PAD, DM, f);
#else
        pg8::Gemm g{WSP(bf16, WS_XN), WSP(bf16, WS_WIN), M, IN_PAD, DM}; pg8::StaticOrder S; S.init(M, IN_PAD, F.G, (int)blockIdx.x);
        pg8::EpiRow<EpiIn<false>> E{{WSP(bf16, WS_QA), WSP(bf16, WS_KA), WSP(bf16, WS_VA), WSP(bf16, WS_CQ), WSP(bf16, WS_CKV), WSP(bf16, WS_KR), WSP(float, WS_SSQ), WSP(float, WS_ROPE)}};
        pg8::gemm_phase<pg8::EpiRow<EpiIn<false>>, pg8::StaticOrder, PG8_ALIGN, PG8_SP2>(F.lds + RING_OFF, g, S, E);
#endif
        if (BOTH(2)) GRID_BAR(2);
    }
    if (IN(3)) {
        for (int gi = 0; gi < 2; ++gi) {
            EpiUp f{WSP(bf16, WS_QB), WSP(bf16, WS_KN), WSP(bf16, WS_VB), WSP(float, WS_SSQ), WSP(float, WS_ROPE), gi};
            const bf16* A = gi ? WSP(bf16, WS_CKV) : WSP(bf16, WS_CQ); const bf16* Bt = gi ? WSP(bf16, WS_WUKV) : WSP(bf16, WS_WUQ);
            const int N = gi ? NKVB : NQB, K = gi ? KVRANK : QRANK;
#if NAIVE_GEMM
            naive_gemm(F, A, Bt, M, N, K, f);
#else
            pg8::Gemm g{A, Bt, M, N, K}; pg8::StaticOrder S; S.init(M, N, F.G, (int)blockIdx.x);
            pg8::EpiRow<EpiUp> E{f}; pg8::gemm_phase<pg8::EpiRow<EpiUp>, pg8::StaticOrder, PG8_ALIGN, PG8_SP2>(F.lds + RING_OFF, g, S, E);
#endif
        }
        if (BOTH(3)) GRID_BAR(3);
    }
    if (IN(4)) {
        naive_swa(F); naive_mla(F);
        __syncthreads();
        if (BOTH(4)) GRID_BAR(4);
    }
    if (IN(5)) {
        EpiRes f{in_ptr(F, 0), F.out, WSP(float, WS_MOD) + 2 * DM};
#if NAIVE_GEMM
        naive_gemm(F, WSP(bf16, WS_MIX), WSP(bf16, WS_WOUT), M, DM, DM, f);
#else
        pg8::Gemm g{WSP(bf16, WS_MIX), WSP(bf16, WS_WOUT), M, DM, DM}; pg8::StaticOrder S; S.init(M, DM, F.G, (int)blockIdx.x);
        pg8::EpiRow<EpiRes> E{f}; pg8::gemm_phase<pg8::EpiRow<EpiRes>, pg8::StaticOrder, PG8_ALIGN, PG8_SP2>(F.lds + RING_OFF, g, S, E);
#endif
        if (BOTH(5)) GRID_BAR(5);
    }
    if (IN(6)) { if (grid_ok) norm_mod_phase<false>(F, F.out, in_ptr(F, 13), 3, 4); __syncthreads(); if (BOTH(6)) GRID_BAR(6); }
    if (IN(7)) {
        EpiRelu2 f{WSP(bf16, WS_H)};
#if NAIVE_GEMM
        naive_gemm(F, WSP(bf16, WS_XN), WSP(bf16, WS_W1), M, FF, DM, f);
#else
        pg8::Gemm g{WSP(bf16, WS_XN), WSP(bf16, WS_W1), M, FF, DM}; pg8::StaticOrder S; S.init(M, FF, F.G, (int)blockIdx.x);
        pg8::EpiRow<EpiRelu2> E{f}; pg8::gemm_phase<pg8::EpiRow<EpiRelu2>, pg8::StaticOrder, PG8_ALIGN, PG8_SP2>(F.lds + RING_OFF, g, S, E);
#endif
        if (BOTH(7)) GRID_BAR(7);
    }
    if (IN(8)) {
        EpiRes f{F.out, F.out, WSP(float, WS_MOD) + 5 * DM};
#if NAIVE_GEMM
        naive_gemm(F, WSP(bf16, WS_H), WSP(bf16, WS_W2), M, DM, FF, f);
#else
        pg8::Gemm g{WSP(bf16, WS_H), WSP(bf16, WS_W2), M, DM, FF}; pg8::StaticOrder S; S.init(M, DM, F.G, (int)blockIdx.x);
        pg8::EpiRow<EpiRes> E{f}; pg8::gemm_phase<pg8::EpiRow<EpiRes>, pg8::StaticOrder, PG8_ALIGN, PG8_SP2>(F.lds + RING_OFF, g, S, E);
#endif
        if (BOTH(8)) GRID_BAR(8);
    }
    if (IN(9)) {
        bool bad = !grid_ok || __hip_atomic_load(F.ctl + CW_TMO, RLX_AGENT) != 0u || __hip_atomic_load((gu32*)((unsigned*)(F.ctl + CW_BAR) + XB_TMO), RLX_AGENT) != 0u;
        if (bad) nan_rows_f32(F, F.out); else final_norm_phase(F);
    }
#undef IN
#undef BOTH
}

extern "C" void kernel_launch(void* const* d_in, const int* in_sizes, int n_in, void* d_out, int out_size, void* d_ws, size_t ws_size, hipStream_t stream) {
    static int grid = 0;
    if (grid == 0) {
        if (n_in != 17 || in_sizes[0] != M * DM || out_size != M * DM || ws_size < WS_END) { fprintf(stderr, "kernel_launch: shape mismatch (n_in %d, in0 %d, out %d, ws %zu)\n", n_in, n_in > 0 ? in_sizes[0] : -1, out_size, ws_size); grid = -1; return; }
        int dev = 0, cus = 0;
        if (hipGetDevice(&dev) != hipSuccess || hipDeviceGetAttribute(&cus, hipDeviceAttributeMultiprocessorCount, dev) != hipSuccess) { grid = -1; return; }
        if (hipFuncSetAttribute((const void*)hymba_fwd, hipFuncAttributeMaxDynamicSharedMemorySize, LDS_BYTES) != hipSuccess) { fprintf(stderr, "kernel_launch: hipFuncSetAttribute failed\n"); grid = -1; return; }
        (void)hipGetLastError();
        grid = cus;
        if (grid != 256) fprintf(stderr, "kernel_launch: %d CUs; this kernel is built for 256\n", grid);
    }
    if (grid < 0) return;
    if (hipMemsetAsync((char*)d_ws + WS_CTL, 0, CTL_ZERO_BYTES, stream) != hipSuccess) { fprintf(stderr, "kernel_launch: memset failed\n"); return; }
    Args a{};
    for (int i = 0; i < 17; ++i) a.in[i] = (const float*)d_in[i];
    a.out = (float*)d_out; a.ws = (unsigned char*)d_ws;
    for (int li = 0; li < N_LAUNCHES; ++li) {
        if (N_LAUNCHES == PER_PHASE) { a.ph_lo = li; a.ph_hi = li + 1; } else { a.ph_lo = 0; a.ph_hi = PER_PHASE; }
        a.li = li;
        hipLaunchKernelGGL(hymba_fwd, dim3(grid), dim3(NWAVES * 64), LDS_BYTES, stream, a);
        const hipError_t le = hipPeekAtLastError();
        if (le != hipSuccess) { fprintf(stderr, "kernel_launch: launch %d failed: %s\n", li, hipGetErrorName(le)); break; }
    }
}
```

```cpp
#include <hip/hip_runtime.h>
#include <cstdio>
#include <cstdint>

#ifndef MK_N_LAUNCHES
#define MK_N_LAUNCHES 1
#endif
#ifndef NAIVE_GEMM
#define NAIVE_GEMM 0
#endif
#ifndef NAIVE_SWA
#define NAIVE_SWA 0
#endif
#ifndef NAIVE_MLA
#define NAIVE_MLA 0
#endif

constexpr int NB = 4, SEQ = 4096, DM = 2048, M = NB * SEQ, FF = 8192;
constexpr int IN_COLS = 1856, IN_PAD = 2048;
constexpr int QRANK = 384, KVRANK = 128, NQB = 1536, NKVB = 2048;
constexpr float EPS = 1e-6f;
constexpr float LOG2E = 1.4426950408889634f;
constexpr float CA = 0.125f * LOG2E;
constexpr float C2M = 0.07216878364870322f * LOG2E;
constexpr int OFF_KA = 1024, OFF_VA = 1152, OFF_CQ = 1280, OFF_CKV = 1664, OFF_KR = 1792;

namespace pg8 {
#define PG8_LAS __attribute__((address_space(3)))
typedef unsigned short bf16_t;
typedef short bf16x8 __attribute__((ext_vector_type(8)));
typedef float f32x4 __attribute__((ext_vector_type(4)));
typedef unsigned u32x4 __attribute__((ext_vector_type(4)));
constexpr int BM = 256, BK = 64, HALF = 128, HTB = HALF * BK * 2, STAGE_BYTES = 8 * HTB, NXCD = 8, WGM = 8;

__host__ __device__ __forceinline__ int lds_byte(int r, int c) { const int st = (r >> 4) * 2 + (c >> 5), rr = r & 15, cc = c & 31, ob = rr * 64 + cc * 2; return st * 1024 + (ob ^ (((ob >> 9) & 1) << 5)); }
__host__ __device__ __forceinline__ void stage_rc(int b, int& R, int& C) { const int st = b / 1024, sb = b % 1024, swz = sb ^ (((sb >> 9) & 1) << 5); R = (st >> 1) * 16 + swz / 64; C = (st & 1) * 32 + (swz % 64) / 2; }
__host__ __device__ __forceinline__ int perm32(int rho) { const int n = rho >> 4, i = rho & 15; return 8 * (i >> 2) + 4 * n + (i & 3); }

struct Unit { int pm, pn; };
struct Gemm { const bf16_t* A; const bf16_t* Bt; int M, N, K; };

struct StaticOrder {
    int nM, nN, nwg, G, c;
    __host__ __device__ void init(int M_, int N_, int G_, int c_) { nM = M_ / BM; nN = N_ / BM; nwg = nM * nN; G = G_; c = c_; }
    __host__ __device__ bool next(int i, Unit& u) const {
        const long L = (long)i * G + c; if (L >= nwg) return false;
        int wgid = (int)L; { const int q = nwg / NXCD, r = nwg % NXCD, xcd = wgid % NXCD, off = wgid / NXCD; wgid = (xcd < r ? xcd * (q + 1) : r * (q + 1) + (xcd - r) * q) + off; }
        const int nig = WGM * nN, gid = wgid / nig, fm = gid * WGM, gsz = (nM - fm) < WGM ? (nM - fm) : WGM;
        u.pm = fm + ((wgid % nig) % gsz); u.pn = (wgid % nig) / gsz; return true;
    }
    __device__ __forceinline__ void a_ready(const Unit&) const {}
    __device__ __forceinline__ void done(const Unit&) const {}
};

__device__ __forceinline__ unsigned cvt_pk_bf16(float lo, float hi) { unsigned r; asm volatile("v_cvt_pk_bf16_f32 %0, %1, %2" : "=v"(r) : "v"(lo), "v"(hi)); return r; }

template <class F> struct EpiRow {
    static constexpr bool PERM = false, AFTER_DRAIN = false;
    F f;
    __device__ __forceinline__ void operator()(const f32x4 (&acc)[2][2][4][2], const Unit& u, int wr, int wc, int fr, int fq) const {
        asm volatile("" : "+v"(fr), "+v"(fq));
        const int colb = u.pn * BM + wc * 32 + 4 * fq;
        const bool slots = f.tile_has_slots(u.pn * BM);
#pragma unroll
        for (int ai = 0; ai < 2; ++ai)
#pragma unroll
            for (int m = 0; m < 4; ++m) {
                const int row = u.pm * BM + ai * HALF + wr * 64 + m * 16 + fr;
                const auto rc = f.row_ctx(row);
#pragma unroll
                for (int bj = 0; bj < 2; ++bj) {
#pragma unroll
                    for (int n = 0; n < 2; ++n) f(rc, row, colb + bj * HALF + n * 16, acc[ai][bj][m][n]);
                    if constexpr (F::HAS_SLOTS) {
                        if (slots) {
                            const f32x4 a = acc[ai][bj][m][0], b = acc[ai][bj][m][1];
                            float s = (a[0] * a[0] + a[1] * a[1]) + (a[2] * a[2] + a[3] * a[3]) + (b[0] * b[0] + b[1] * b[1]) + (b[2] * b[2] + b[3] * b[3]);
                            s += __shfl_xor(s, 16); s += __shfl_xor(s, 32);
                            if (fq == 0) f.slot_store(row, u.pn * BM + bj * HALF + wc * 32, s);
                        }
                    }
                }
                asm volatile("" ::: "memory");
            }
    }
};

template <class Epi, class Sched, bool ALIGN_EPI = false, bool SP2 = false>
__device__ __forceinline__ void gemm_phase(PG8_LAS unsigned char* lds, const Gemm g, const Sched& S, const Epi& E) {
    const int tid = threadIdx.x, wid = __builtin_amdgcn_readfirstlane(tid >> 6), lane = tid & 63, wr = wid >> 2, wc = wid & 3, fr = lane & 15, fq = lane >> 4;
    const int K = g.K, nt = K / BK;
    unsigned voffA[2], voffB[2];
#pragma unroll
    for (int i = 0; i < 2; ++i) { int R, C; stage_rc(tid * 16 + i * 8192, R, C); const int Rb = Epi::PERM ? ((R & ~31) + perm32(R & 31)) : R;
        voffA[i] = (unsigned)(R * K + C) * 2u; voffB[i] = (unsigned)(Rb * K + C) * 2u; }
    const size_t kstep = (size_t)(BK * 2);
    const size_t hstep = (size_t)HALF * K * 2;
    const size_t tstep = 2 * hstep;
    const unsigned ldsw = (unsigned)wid * 1024u;
    const int aoff = lds_byte(wr * 64 + fr, fq * 8), boff = lds_byte(wc * 32 + fr, fq * 8);
#define PG8_SA(b, h) (((b) * 2 + (h)) * HTB)
#define PG8_SB(b, h) ((4 + (b) * 2 + (h)) * HTB)
#define PG8_STAGE(bufoff, gbase, voff) do { _Pragma("unroll") for (int _i = 0; _i < 2; ++_i) \
        __builtin_amdgcn_global_load_lds((const unsigned*)((const char*)(gbase) + (voff)[_i]), (PG8_LAS unsigned*)(lds + (bufoff) + ldsw + _i * 8192), 16, 0, 0); } while (0)
#define PG8_LDA(dst, b, h) do { _Pragma("unroll") for (int m = 0; m < 4; ++m) _Pragma("unroll") for (int k = 0; k < 2; ++k) dst[m][k] = *(const PG8_LAS bf16x8*)(lds + PG8_SA(b, h) + aoff + m * 2048 + k * 1024); } while (0)
#define PG8_LDB(dst, b, h) do { _Pragma("unroll") for (int n = 0; n < 2; ++n) _Pragma("unroll") for (int k = 0; k < 2; ++k) dst[n][k] = *(const PG8_LAS bf16x8*)(lds + PG8_SB(b, h) + boff + n * 2048 + k * 1024); } while (0)
#define PG8_MMA(ai, bj, At, Bt) do { __builtin_amdgcn_s_setprio(1); _Pragma("unroll") for (int m = 0; m < 4; ++m) _Pragma("unroll") for (int n = 0; n < 2; ++n) _Pragma("unroll") for (int k = 0; k < 2; ++k) \
        acc[ai][bj][m][n] = __builtin_amdgcn_mfma_f32_16x16x32_bf16(Bt[n][k], At[m][k], acc[ai][bj][m][n], 0, 0, 0); __builtin_amdgcn_s_setprio(0); } while (0)
#define PG8_WAIT_V(n) asm volatile("s_waitcnt vmcnt(" #n ")" ::: "memory")
#define PG8_WAIT_L(n) asm volatile("s_waitcnt lgkmcnt(" #n ")" ::: "memory")
#define PG8_BAR __builtin_amdgcn_s_barrier()
#define PG8_SCHED __builtin_amdgcn_sched_barrier(0)
    Unit cur, nxt; int ui = 0;
    if (!S.next(0, cur)) return;
    f32x4 acc[2][2][4][2];
#pragma unroll
    for (int a = 0; a < 2; ++a)
#pragma unroll
        for (int b = 0; b < 2; ++b)
#pragma unroll
            for (int m = 0; m < 4; ++m)
#pragma unroll
                for (int n = 0; n < 2; ++n) acc[a][b][m][n] = (f32x4){0.f, 0.f, 0.f, 0.f};
    bf16x8 At[4][2], B0[2][2], B1[2][2];
    const char* cA = (const char*)g.A + (size_t)cur.pm * tstep; const char* cB = (const char*)g.Bt + (size_t)cur.pn * tstep;
    S.a_ready(cur);
    if constexpr (SP2) {
        PG8_STAGE(PG8_SB(0, 0), cB, voffB); PG8_STAGE(PG8_SB(0, 1), cB + hstep, voffB); PG8_STAGE(PG8_SA(0, 0), cA, voffA); PG8_STAGE(PG8_SA(0, 1), cA + hstep, voffA);
        if (wr == 1) PG8_BAR;
        PG8_WAIT_V(2); PG8_BAR;
        PG8_STAGE(PG8_SB(1, 0), cB + kstep, voffB); PG8_STAGE(PG8_SA(1, 0), cA + kstep, voffA); PG8_STAGE(PG8_SB(1, 1), cB + hstep + kstep, voffB);
        PG8_WAIT_V(6); PG8_BAR;
    } else {
        PG8_STAGE(PG8_SB(0, 0), cB, voffB); PG8_STAGE(PG8_SA(0, 0), cA, voffA); PG8_STAGE(PG8_SB(0, 1), cB + hstep, voffB); PG8_STAGE(PG8_SA(0, 1), cA + hstep, voffA);
        if (wr == 1) PG8_BAR;
        PG8_WAIT_V(4); PG8_BAR;
        PG8_STAGE(PG8_SB(1, 0), cB + kstep, voffB); PG8_STAGE(PG8_SA(1, 0), cA + kstep, voffA); PG8_STAGE(PG8_SB(1, 1), cB + hstep + kstep, voffB);
        PG8_WAIT_V(6); PG8_BAR;
    }
    for (;;) {
        const bool has_next = S.next(ui + 1, nxt);
        const char* nA = has_next ? (const char*)g.A + (size_t)nxt.pm * tstep : cA; const char* nB = has_next ? (const char*)g.Bt + (size_t)nxt.pn * tstep : cB;
        for (int t = 0; t < nt; t += 2) {
            const bool last = (t == nt - 2);
            const char* a1 = cA + (size_t)(t + 1) * kstep;
            const char* a2 = last ? nA : cA + (size_t)(t + 2) * kstep; const char* b2 = last ? nB : cB + (size_t)(t + 2) * kstep;
            const char* a3 = a2 + kstep; const char* b3 = b2 + kstep;
            if (last && has_next) S.a_ready(nxt);
            if constexpr (SP2) {
            PG8_LDB(B0, 0, 0); PG8_LDB(B1, 0, 1); PG8_SCHED; PG8_LDA(At, 0, 0); PG8_STAGE(PG8_SA(1, 1), a1 + hstep, voffA);
            PG8_WAIT_V(8); PG8_WAIT_L(0); PG8_BAR; PG8_MMA(0, 0, At, B0); PG8_MMA(0, 1, At, B1); PG8_BAR; PG8_SCHED;
            PG8_LDA(At, 0, 1); PG8_STAGE(PG8_SB(0, 0), b2, voffB); PG8_STAGE(PG8_SB(0, 1), b2 + hstep, voffB); PG8_STAGE(PG8_SA(0, 0), a2, voffA);
            PG8_WAIT_V(8); PG8_WAIT_L(0); PG8_BAR; PG8_MMA(1, 0, At, B0); PG8_MMA(1, 1, At, B1); PG8_BAR; PG8_SCHED;
            PG8_LDB(B0, 1, 0); PG8_LDB(B1, 1, 1); PG8_SCHED; PG8_LDA(At, 1, 0); PG8_STAGE(PG8_SA(0, 1), a2 + hstep, voffA);
            PG8_WAIT_V(8); PG8_WAIT_L(0); PG8_BAR; PG8_MMA(0, 0, At, B0); PG8_MMA(0, 1, At, B1); PG8_BAR; PG8_SCHED;
            PG8_LDA(At, 1, 1); PG8_STAGE(PG8_SB(1, 0), b3, voffB); PG8_STAGE(PG8_SB(1, 1), b3 + hstep, voffB); PG8_STAGE(PG8_SA(1, 0), a3, voffA);
            PG8_WAIT_V(8); PG8_WAIT_L(0); PG8_BAR; PG8_MMA(1, 0, At, B0); PG8_MMA(1, 1, At, B1); PG8_BAR; PG8_SCHED;
            } else {
            PG8_LDB(B0, 0, 0); PG8_SCHED; PG8_LDA(At, 0, 0); PG8_STAGE(PG8_SA(1, 1), a1 + hstep, voffA);
            PG8_WAIT_L(8); PG8_BAR; PG8_WAIT_L(0); PG8_MMA(0, 0, At, B0); PG8_BAR; PG8_SCHED;
            PG8_LDB(B1, 0, 1); PG8_STAGE(PG8_SB(0, 0), b2, voffB);
            PG8_BAR; PG8_WAIT_L(0); PG8_MMA(0, 1, At, B1); PG8_BAR;
            PG8_LDA(At, 0, 1); PG8_STAGE(PG8_SA(0, 0), a2, voffA);
            PG8_BAR; PG8_WAIT_L(0); PG8_MMA(1, 0, At, B0); PG8_BAR; PG8_SCHED;
            PG8_STAGE(PG8_SB(0, 1), b2 + hstep, voffB);
            PG8_WAIT_V(6); PG8_BAR; PG8_MMA(1, 1, At, B1); PG8_BAR;
            PG8_LDB(B0, 1, 0); PG8_SCHED; PG8_LDA(At, 1, 0); PG8_STAGE(PG8_SA(0, 1), a2 + hstep, voffA);
            PG8_WAIT_L(8); PG8_BAR; PG8_WAIT_L(0); PG8_MMA(0, 0, At, B0); PG8_BAR; PG8_SCHED;
            PG8_LDB(B1, 1, 1); PG8_STAGE(PG8_SB(1, 0), b3, voffB);
            PG8_BAR; PG8_WAIT_L(0); PG8_MMA(0, 1, At, B1); PG8_BAR;
            PG8_LDA(At, 1, 1); PG8_STAGE(PG8_SA(1, 0), a3, voffA);
            PG8_BAR; PG8_WAIT_L(0); PG8_MMA(1, 0, At, B0); PG8_BAR; PG8_SCHED;
            PG8_STAGE(PG8_SB(1, 1), b3 + hstep, voffB);
            PG8_WAIT_V(6); PG8_BAR; PG8_MMA(1, 1, At, B1); PG8_BAR;
            }
        }
        if constexpr (ALIGN_EPI) { if (wr == 0) PG8_BAR; }
        if constexpr (!Epi::AFTER_DRAIN) { E(acc, cur, wr, wc, fr, fq); S.done(cur); }
        if (!has_next) break;
#pragma unroll
        for (int a = 0; a < 2; ++a)
#pragma unroll
            for (int b = 0; b < 2; ++b)
#pragma unroll
                for (int m = 0; m < 4; ++m)
#pragma unroll
                    for (int n = 0; n < 2; ++n) acc[a][b][m][n] = (f32x4){0.f, 0.f, 0.f, 0.f};
        cur = nxt; cA = nA; cB = nB; ++ui;
        if constexpr (ALIGN_EPI) { if (wr == 1) PG8_BAR; }
    }
    PG8_WAIT_V(0);
    if constexpr (!ALIGN_EPI) { if (wr == 0) PG8_BAR; }
    PG8_BAR;
#undef PG8_SA
#undef PG8_SB
#undef PG8_STAGE
#undef PG8_LDA
#undef PG8_LDB
#undef PG8_MMA
#undef PG8_WAIT_V
#undef PG8_WAIT_L
#undef PG8_BAR
#undef PG8_SCHED
}
}

#ifndef PG8_SP2
#define PG8_SP2 true
#endif
#ifndef PG8_ALIGN
#define PG8_ALIGN true
#endif

constexpr int NWAVES = 8;
constexpr int N_LAUNCHES = MK_N_LAUNCHES;
constexpr int PER_PHASE = 10;

constexpr size_t MiB = 1u << 20;
constexpr size_t WS_CTL = 0, CTL_ZERO_BYTES = 2 * MiB;
constexpr size_t WS_SSQ = 1 * MiB;
constexpr size_t WS_MOD = 2 * MiB;
constexpr size_t WS_BIAS = 2 * MiB + 512 * 1024;
constexpr size_t WS_ROPE = 3 * MiB;
constexpr size_t WS_PART = 4 * MiB;
constexpr size_t WS_WIN = 8 * MiB;
constexpr size_t WS_WUQ = 16 * MiB;
constexpr size_t WS_WUKV = 18 * MiB;
constexpr size_t WS_WOUT = 20 * MiB;
constexpr size_t WS_W1 = 28 * MiB;
constexpr size_t WS_W2 = 60 * MiB;
constexpr size_t WS_H = 92 * MiB;
constexpr size_t WS_QA = 92 * MiB;
constexpr size_t WS_KA = 124 * MiB;
constexpr size_t WS_VA = 128 * MiB;
constexpr size_t WS_CQ = 132 * MiB;
constexpr size_t WS_CKV = 144 * MiB;
constexpr size_t WS_KR = 148 * MiB;
constexpr size_t WS_QB = 150 * MiB;
constexpr size_t WS_KN = 198 * MiB;
constexpr size_t WS_VB = 230 * MiB;
constexpr size_t WS_MIX = 262 * MiB;
constexpr size_t WS_XN = 348 * MiB;
constexpr size_t WS_END = 412 * MiB;
static_assert(WS_MIX + (size_t)M * DM * 2 <= WS_H + (size_t)M * FF * 2 && WS_H + (size_t)M * FF * 2 <= WS_XN && WS_XN + (size_t)M * DM * 2 <= WS_END, "d_ws map");
constexpr int CW_TMO = 0, CW_CODE = 1;
constexpr int CW_BAR = 4096;

constexpr int RING_OFF = 0, RING_BYTES = 131072;
constexpr int LDSCTL_OFF = RING_BYTES, MISC_OFF = LDSCTL_OFF + 320;
constexpr int LDS_EXTRA_OFF = 132 * 1024;
constexpr int LDS_BYTES = 147456;

#define GAS __attribute__((address_space(1)))
#define LAS __attribute__((address_space(3)))
typedef unsigned short bf16;
typedef unsigned v4u __attribute__((ext_vector_type(4)));
typedef unsigned v2u __attribute__((ext_vector_type(2)));
typedef float f32x4 __attribute__((ext_vector_type(4)));
typedef float f32x2 __attribute__((ext_vector_type(2)));
typedef short bf16x8 __attribute__((ext_vector_type(8)));
typedef GAS unsigned gu32;
#define RLX_AGENT __ATOMIC_RELAXED, __HIP_MEMORY_SCOPE_AGENT
#define LDS_WAIT() asm volatile("s_waitcnt lgkmcnt(0)" ::: "memory")
#define VM_WAIT() asm volatile("s_waitcnt vmcnt(0)" ::: "memory")
__device__ __forceinline__ unsigned f2bf(float f) { unsigned u = __builtin_bit_cast(unsigned, f); return (u + 0x7fffu + ((u >> 16) & 1u)) >> 16; }
__device__ __forceinline__ unsigned pk2(float lo, float hi) { return f2bf(lo) | (f2bf(hi) << 16); }
__device__ __forceinline__ float bf2f(unsigned h) { return __builtin_bit_cast(float, h << 16); }

#define XB_TMO      128
#define XB_XCNT(j)  (256  + 64 * (j))
#define XB_XSUB(j)  (1280 + 64 * (j))
#define XB_XGEN(j)  (2304 + 64 * (j))
#define XB_TOP      3328
#define XB_TOPGEN   3392
#define XCD_BAR_WORDS 3456
#define XB_SPIN_CAP (1u << 18)
__device__ __forceinline__ unsigned xb_ld(unsigned* p)              { return __hip_atomic_load(p, __ATOMIC_RELAXED, __HIP_MEMORY_SCOPE_AGENT); }
__device__ __forceinline__ unsigned xb_add(unsigned* p, unsigned v) { return __hip_atomic_fetch_add(p, v, __ATOMIC_RELAXED, __HIP_MEMORY_SCOPE_AGENT); }
__device__ __forceinline__ unsigned xb_xcc_id() { return (unsigned)__builtin_amdgcn_s_getreg((3 << 11) | 20) & 0xFu; }
#define XB_SPIN(cond, bar) do { unsigned _sp = 0; while (cond) { __builtin_amdgcn_s_sleep(1); \
    if ((++_sp & 255u) == 0u) { if (xb_ld(&(bar)[XB_TMO])) break; if (_sp > XB_SPIN_CAP) { atomicAdd(&(bar)[XB_TMO], 1u); break; } } } } while (0)
struct XcdBarrier { unsigned* bar; unsigned x; volatile LAS unsigned* st; };
__device__ __forceinline__ XcdBarrier xcd_barrier_post(unsigned* bar, volatile LAS unsigned* st) {
    XcdBarrier b; b.bar = bar; b.x = xb_xcc_id(); b.st = st;
    if (threadIdx.x == 0) (void)xb_add(&bar[XB_XCNT(b.x)], 1u);
    return b;
}
__device__ __forceinline__ void xcd_barrier_complete(unsigned* bar, unsigned x, unsigned& nloc, unsigned& nx) {
    const unsigned G = gridDim.x * gridDim.y * gridDim.z;
    unsigned sum, cnt, mine, sp = 0u;
    for (;;) {
        sum = 0u; cnt = 0u; mine = 0u;
#pragma unroll
        for (unsigned j = 0; j < 16; ++j) { const unsigned c = xb_ld(&bar[XB_XCNT(j)]); sum += c; cnt += (c > 0u) ? 1u : 0u; mine = (j == x) ? c : mine; }
        if (sum == G) break;
        __builtin_amdgcn_s_sleep(1);
        if ((++sp & 255u) == 0u) { if (xb_ld(&bar[XB_TMO])) break; if (sp > XB_SPIN_CAP) { atomicAdd(&bar[XB_TMO], 1u); break; } }
    }
    nloc = mine > 0u ? mine : 1u; nx = cnt > 0u ? cnt : 1u;
}
__device__ __forceinline__ void xcd_barrier(const XcdBarrier& b) {
    asm volatile("s_waitcnt vmcnt(0)" ::: "memory");
    __syncthreads();
    if (threadIdx.x == 0) {
        unsigned* bar = b.bar;
        __builtin_amdgcn_s_waitcnt(0);
        unsigned nloc = b.st[0], nx = b.st[1];
        if (nloc == 0u) { xcd_barrier_complete(bar, b.x, nloc, nx); b.st[0] = nloc; b.st[1] = nx; }
        const unsigned old = xb_add(&bar[XB_XSUB(b.x)], 1u);
        const unsigned gen = old / nloc;
        if (old + 1u == (gen + 1u) * nloc) {
            __builtin_amdgcn_fence(__ATOMIC_RELEASE, "agent");
            asm volatile("s_waitcnt vmcnt(0)" ::: "memory");
            const unsigned og = xb_add(&bar[XB_TOP], 1u);
            const unsigned tg = og / nx;
            if (og + 1u == (tg + 1u) * nx) xb_add(&bar[XB_TOPGEN], 1u);
            else XB_SPIN(xb_ld(&bar[XB_TOPGEN]) == tg, bar);
            __builtin_amdgcn_fence(__ATOMIC_ACQUIRE, "agent");
            xb_add(&bar[XB_XGEN(b.x)], 1u);
            asm volatile("s_waitcnt vmcnt(0)" ::: "memory");
        } else {
            XB_SPIN(xb_ld(&bar[XB_XGEN(b.x)]) == gen, bar);
            __builtin_amdgcn_fence(__ATOMIC_ACQUIRE, "agent");
            asm volatile("s_waitcnt vmcnt(0)" ::: "memory");
        }
    }
    __syncthreads();
}

struct Frame {
    LAS unsigned char* lds;
    volatile LAS unsigned* MISC;
    gu32* ctl;
    int tid, lane, wave;
    int vcu, G;
    unsigned char* ws; float* out;
};
constexpr int INPTR_OFF = LDSCTL_OFF + 512;
__device__ __forceinline__ const float* in_ptr(const Frame& F, int k) {
    const unsigned long long v = ((const LAS unsigned long long*)(F.lds + INPTR_OFF))[k];
    const unsigned lo = __builtin_amdgcn_readfirstlane((unsigned)v), hi = __builtin_amdgcn_readfirstlane((unsigned)(v >> 32));
    return (const float*)(((unsigned long long)hi << 32) | lo);
}
#define WSP(T, off) ((T*)(F.ws + (off)))


__device__ __forceinline__ float wave_sum(float v) {
#pragma unroll
    for (int o = 1; o < 64; o <<= 1) v += __shfl_xor(v, o);
    return v;
}
__device__ __forceinline__ float wave_max(float v) {
#pragma unroll
    for (int o = 1; o < 64; o <<= 1) v = fmaxf(v, __shfl_xor(v, o));
    return v;
}

__device__ __forceinline__ int t5_bucket(int n) {
    if (n < 16) return n;
    const unsigned char T[112] = {16,16,16,17,17,18,18,18,19,19,19,20,20,20,20,21,21,21,21,22,22,22,22,22,23,23,23,23,23,23,24,24,24,24,24,24,25,25,25,25,25,25,25,26,26,26,26,26,26,26,26,27,27,27,27,27,27,27,27,27,27,28,28,28,28,28,28,28,28,28,28,29,29,29,29,29,29,29,29,29,29,29,29,30,30,30,30,30,30,30,30,30,30,30,30,30,30,31,31,31,31,31,31,31,31,31,31,31,31,31,31,31};
    return T[n - 16];
}

__device__ __forceinline__ void sincos_acc(float ang, float& s_out, float& c_out) {
    const double x = (double)ang;
    const double k = __builtin_rint(x * 0.15915494309189535);
    double r = __builtin_fma(-k, 6.283185307179586, x); r = __builtin_fma(-k, 2.4492935982947064e-16, r);
    const double y = r * 0.25, y2 = y * y;
    double s = y * (1.0 + y2 * (-1.0 / 6 + y2 * (1.0 / 120 + y2 * (-1.0 / 5040 + y2 * (1.0 / 362880 + y2 * (-1.0 / 39916800 + y2 * (1.0 / 6227020800.0)))))));
    double c = 1.0 + y2 * (-0.5 + y2 * (1.0 / 24 + y2 * (-1.0 / 720 + y2 * (1.0 / 40320 + y2 * (-1.0 / 3628800 + y2 * (1.0 / 479001600.0))))));
    double s2 = 2.0 * s * c, c2 = 1.0 - 2.0 * s * s;
    double s4 = 2.0 * s2 * c2, c4 = 1.0 - 2.0 * s2 * s2;
    s_out = (float)s4; c_out = (float)c4;
}

template <int MODE> __device__ __forceinline__ int dst_row(int n) {
    if (MODE == 1) { if (n >= OFF_KR) { const int j = n - OFF_KR; return OFF_KR + 2 * (j & 31) + (j >> 5); } return n; }
    if (MODE == 2) { const int h = n / 192, w = n - h * 192; if (w >= 128) { const int j = w - 128; return h * 192 + 128 + 2 * (j & 31) + (j >> 5); } return n; }
    return n;
}
template <int MODE> __device__ __forceinline__ void p0_transpose_item(const float* W, int K, int N, bf16* WT, LAS float* scr, int item, int lane, const float* gs) {
    const int nblk = N / 32, kb = item / nblk, nb = item % nblk, k0 = 64 * kb, n0 = 32 * nb;
#pragma unroll 8
    for (int i = 0; i < 32; ++i) { const int kk = 2 * i + (lane >> 5); scr[kk * 33 + (lane & 31)] = W[(size_t)(k0 + kk) * N + n0 + (lane & 31)]; }
    LDS_WAIT(); asm volatile("" ::: "memory");
    const int c = lane & 7;
    float g[8];
#pragma unroll
    for (int e = 0; e < 8; ++e) g[e] = gs ? gs[k0 + 8 * c + e] : 1.0f;
#pragma unroll
    for (int j = 0; j < 4; ++j) { const int n = (lane >> 3) + 8 * j; const LAS float* s = scr + (8 * c) * 33 + n;
        v4u o; o.x = pk2(s[0 * 33] * g[0], s[1 * 33] * g[1]); o.y = pk2(s[2 * 33] * g[2], s[3 * 33] * g[3]); o.z = pk2(s[4 * 33] * g[4], s[5 * 33] * g[5]); o.w = pk2(s[6 * 33] * g[6], s[7 * 33] * g[7]);
        *(GAS v4u*)(WT + (size_t)dst_row<MODE>(n0 + n) * K + k0 + 8 * c) = o; }
    LDS_WAIT(); asm volatile("" ::: "memory");
}
constexpr int MOD_KS = 16, MOD_N = 6 * DM, MOD_CG = MOD_N / 256;
__device__ __forceinline__ void p0_prologue(Frame& F) {
    LAS float* sil = (LAS float*)(F.lds + RING_OFF);
    LAS float* scr = (LAS float*)(F.lds + RING_OFF + 32768 + F.wave * 8704);
    for (int i = F.tid; i < NB * DM; i += NWAVES * 64) { const float v = in_ptr(F, 1)[i]; sil[i] = v / (1.0f + __expf(-v)); }
    __syncthreads();
    const int gw = F.vcu * NWAVES + F.wave, NGW = F.G * NWAVES, lane = F.lane;
    constexpr int T_MOD = MOD_KS * MOD_CG;
    constexpr int I_IN = (DM / 64) * (IN_COLS / 32), I_UQ = (QRANK / 64) * (NQB / 32), I_UKV = (KVRANK / 64) * (NKVB / 32), I_OUT = (DM / 64) * (DM / 32), I_1 = (DM / 64) * (FF / 32), I_2 = (FF / 64) * (DM / 32);
    constexpr int T_PAD = IN_PAD - IN_COLS, T_ROPE = SEQ * 32 / 64, T_BIAS = 16 * 128 / 64;
    constexpr int NT = T_MOD + I_IN + I_UQ + I_UKV + I_OUT + I_1 + I_2 + T_PAD + T_ROPE + T_BIAS;
    for (int it = gw; it < NT; it += NGW) {
        int r = it;
        if (r < T_MOD) {
            const int cg = r % MOD_CG, ks = r / MOD_CG, j0 = cg * 256 + 4 * lane, k0 = ks * (DM / MOD_KS);
            f32x4 acc[4] = {{0.f, 0.f, 0.f, 0.f}, {0.f, 0.f, 0.f, 0.f}, {0.f, 0.f, 0.f, 0.f}, {0.f, 0.f, 0.f, 0.f}};
            for (int kk = 0; kk < DM / MOD_KS; kk += 8) {
                f32x4 w[8];
#pragma unroll
                for (int u = 0; u < 8; ++u) w[u] = *(const GAS f32x4*)(in_ptr(F, 2) + (size_t)(k0 + kk + u) * MOD_N + j0);
#pragma unroll
                for (int u = 0; u < 8; ++u)
#pragma unroll
                    for (int b = 0; b < 4; ++b) acc[b] += sil[b * DM + k0 + kk + u] * w[u];
            }
#pragma unroll
            for (int b = 0; b < 4; ++b) *(GAS f32x4*)(WSP(float, WS_PART) + (size_t)(ks * 4 + b) * MOD_N + j0) = acc[b];
            continue;
        }
        r -= T_MOD;
        if (r < I_IN) { p0_transpose_item<1>(in_ptr(F, 5), DM, IN_COLS, WSP(bf16, WS_WIN), scr, r, lane, nullptr); continue; } r -= I_IN;
        if (r < I_UQ) { p0_transpose_item<2>(in_ptr(F, 9), QRANK, NQB, WSP(bf16, WS_WUQ), scr, r, lane, in_ptr(F, 8)); continue; } r -= I_UQ;
        if (r < I_UKV) { p0_transpose_item<0>(in_ptr(F, 11), KVRANK, NKVB, WSP(bf16, WS_WUKV), scr, r, lane, in_ptr(F, 10)); continue; } r -= I_UKV;
        if (r < I_OUT) { p0_transpose_item<0>(in_ptr(F, 12), DM, DM, WSP(bf16, WS_WOUT), scr, r, lane, nullptr); continue; } r -= I_OUT;
        if (r < I_1) { p0_transpose_item<0>(in_ptr(F, 14), DM, FF, WSP(bf16, WS_W1), scr, r, lane, nullptr); continue; } r -= I_1;
        if (r < I_2) { p0_transpose_item<0>(in_ptr(F, 15), FF, DM, WSP(bf16, WS_W2), scr, r, lane, nullptr); continue; } r -= I_2;
        if (r < T_PAD) {
            GAS v4u* o = (GAS v4u*)(WSP(bf16, WS_WIN) + (size_t)(IN_COLS + r) * DM) + lane;
#pragma unroll
            for (int j = 0; j < 4; ++j) o[64 * j] = (v4u){0u, 0u, 0u, 0u};
            continue;
        }
        r -= T_PAD;
        if (r < T_ROPE) {
            const int pos = 2 * r + (lane >> 5), i = lane & 31;
            double f = 1.0; for (int e = 0; e < i; ++e) f *= 0.7498942093324559;
            const float ang = (float)pos * (float)f;
            float s, c; sincos_acc(ang, s, c);
            *(GAS f32x2*)(WSP(float, WS_ROPE) + ((size_t)pos * 32 + i) * 2) = (f32x2){c, s};
            continue;
        }
        r -= T_ROPE;
        { const int e = r * 64 + lane, head = e >> 7, dist = e & 127;
          WSP(float, WS_BIAS)[e] = in_ptr(F, 7)[t5_bucket(dist) * 16 + head] * LOG2E; }
    }
}

template <bool FROM_PART> __device__ __forceinline__ void norm_mod_phase(Frame& F, const float* xin, const float* gvec, int sh_chunk, int sc_chunk) {
    LAS f32x2* ab = (LAS f32x2*)(F.lds + RING_OFF);
    const int b = F.vcu / (SEQ / 64);
    for (int k = F.tid; k < DM; k += NWAVES * 64) {
        float sc, sh;
        if (FROM_PART) { sc = in_ptr(F, 3)[sc_chunk * DM + k]; sh = in_ptr(F, 3)[sh_chunk * DM + k];
#pragma unroll 4
            for (int ks = 0; ks < MOD_KS; ++ks) { const float* p = WSP(float, WS_PART) + (size_t)(ks * 4 + b) * MOD_N; sc += p[sc_chunk * DM + k]; sh += p[sh_chunk * DM + k]; } }
        else { sc = WSP(float, WS_MOD)[b * MOD_N + sc_chunk * DM + k]; sh = WSP(float, WS_MOD)[b * MOD_N + sh_chunk * DM + k]; }
        ab[k] = (f32x2){gvec[k] * (1.0f + sc), sh};
    }
    if (FROM_PART) {
        const int o = F.vcu * (NB * MOD_N / 256) + F.tid;
        if (F.tid < NB * MOD_N / 256) { const int bb = o / MOD_N, j = o - bb * MOD_N; float s = in_ptr(F, 3)[j];
            for (int ks = 0; ks < MOD_KS; ++ks) s += WSP(float, WS_PART)[(size_t)(ks * 4 + bb) * MOD_N + j];
            WSP(float, WS_MOD)[o] = s; }
    }
    __syncthreads();
    for (int i = 0; i < 8; ++i) {
        const int row = F.vcu * 64 + F.wave * 8 + i;
        const GAS f32x4* xr = (const GAS f32x4*)(xin + (size_t)row * DM) + F.lane;
        f32x4 v[8]; float s = 0.f;
#pragma unroll
        for (int j = 0; j < 8; ++j) { v[j] = xr[64 * j]; s += (v[j].x * v[j].x + v[j].y * v[j].y) + (v[j].z * v[j].z + v[j].w * v[j].w); }
        const float rstd = 1.0f / sqrtf(wave_sum(s) * (1.0f / DM) + EPS);
        GAS v2u* o8 = (GAS v2u*)(WSP(bf16, WS_XN) + (size_t)row * DM) + F.lane;
#pragma unroll
        for (int j = 0; j < 8; ++j) { const int k = 4 * (F.lane + 64 * j);
            const f32x2 a0 = ab[k], a1 = ab[k + 1], a2 = ab[k + 2], a3 = ab[k + 3];
            o8[64 * j] = (v2u){pk2(v[j].x * rstd * a0.x + a0.y, v[j].y * rstd * a1.x + a1.y), pk2(v[j].z * rstd * a2.x + a2.y, v[j].w * rstd * a3.x + a3.y)}; }
    }
}
__device__ __forceinline__ void final_norm_phase(Frame& F) {
    const int gw = F.vcu * NWAVES + F.wave, NGW = F.G * NWAVES;
    f32x4 g[8];
#pragma unroll
    for (int j = 0; j < 8; ++j) g[j] = *((const GAS f32x4*)in_ptr(F, 16) + F.lane + 64 * j);
    for (int row = gw; row < M; row += NGW) {
        GAS f32x4* xr = (GAS f32x4*)(F.out + (size_t)row * DM) + F.lane;
        f32x4 v[8]; float s = 0.f;
#pragma unroll
        for (int j = 0; j < 8; ++j) { v[j] = xr[64 * j]; s += (v[j].x * v[j].x + v[j].y * v[j].y) + (v[j].z * v[j].z + v[j].w * v[j].w); }
        const float rstd = 1.0f / sqrtf(wave_sum(s) * (1.0f / DM) + EPS);
#pragma unroll
        for (int j = 0; j < 8; ++j) xr[64 * j] = v[j] * rstd * g[j];
    }
}
__device__ __forceinline__ void nan_rows_f32(Frame& F, float* out) {
    const int gw = F.vcu * NWAVES + F.wave, NGW = F.G * NWAVES; const float q = __builtin_nanf("");
    for (int m = gw; m < M; m += NGW) { GAS f32x4* o = (GAS f32x4*)(out + (size_t)m * DM) + F.lane;
#pragma unroll
        for (int j = 0; j < 8; ++j) o[64 * j] = (f32x4){q, q, q, q}; }
}

struct NoCtx {};
__device__ __forceinline__ void st_bf4(bf16* base, unsigned off, f32x4 v) { *(GAS v2u*)(base + off) = (v2u){pk2(v[0], v[1]), pk2(v[2], v[3])}; }
__device__ __forceinline__ f32x4 rope4(const float* ROPE, unsigned pos, unsigned p, f32x4 v) {
    const f32x4 cs = *(const GAS f32x4*)(ROPE + (pos * 64u + p));
    return (f32x4){v[0] * cs[0] - v[1] * cs[1], v[1] * cs[0] + v[0] * cs[1], v[2] * cs[2] - v[3] * cs[3], v[3] * cs[2] + v[2] * cs[3]};
}
template <bool ATOMIC> struct EpiIn {
    static constexpr bool HAS_SLOTS = true;
    bf16 *QA, *KA, *VA, *CQ, *CKV, *KR; float* SSQ; const float* ROPE;
    __device__ __forceinline__ bool tile_has_slots(int col0) const { return !ATOMIC && col0 >= OFF_CQ && col0 < OFF_KR; }
    __device__ __forceinline__ NoCtx row_ctx(int) const { return NoCtx{}; }
    __device__ __forceinline__ void slot_store(int row, int col32, float s) const { if (col32 >= OFF_CQ && col32 < OFF_KR) SSQ[(unsigned)row * 16u + (unsigned)((col32 - OFF_CQ) >> 5)] = s; }
    __device__ __forceinline__ void operator()(NoCtx, int row, int col, f32x4 v) const {
        const int reg = __builtin_amdgcn_readfirstlane(col >> 7);
        const unsigned r = (unsigned)row, c = (unsigned)col;
        if (reg < 8) { st_bf4(QA, r * 1024u + c, v * CA); }
        else if (reg == 8) { st_bf4(KA, r * 128u + (c - OFF_KA), v); }
        else if (reg == 9) { st_bf4(VA, r * 128u + (c - OFF_VA), v); }
        else if (reg < 14) {
            if (reg < 13) st_bf4(CQ, r * QRANK + (c - OFF_CQ), v); else st_bf4(CKV, r * KVRANK + (c - OFF_CKV), v);
            if (ATOMIC) atomicAdd(SSQ + (r * 16u + ((c - OFF_CQ) >> 5)), (v[0] * v[0] + v[1] * v[1]) + (v[2] * v[2] + v[3] * v[3]));
        }
        else if (reg == 14) { if (col < IN_COLS) st_bf4(KR, r * 64u + (c - OFF_KR), rope4(ROPE, r & (SEQ - 1), c - OFF_KR, v)); }
    }
};
struct EpiUp {
    static constexpr bool HAS_SLOTS = false;
    bf16 *QB, *KN, *VB; const float* SSQ; const float* ROPE; int mode;
    __device__ __forceinline__ bool tile_has_slots(int) const { return false; }
    __device__ __forceinline__ void slot_store(int, int, float) const {}
    __device__ __forceinline__ float row_ctx(int row) const {
        const GAS f32x4* s = (const GAS f32x4*)(SSQ + (unsigned)row * 16u);
        if (mode == 0) { const f32x4 a = s[0], b = s[1], c = s[2];
            const float t = ((a[0] + a[1]) + (a[2] + a[3])) + ((b[0] + b[1]) + (b[2] + b[3])) + ((c[0] + c[1]) + (c[2] + c[3]));
            return C2M * __builtin_amdgcn_rsqf(t * (1.0f / QRANK) + EPS); }
        const f32x4 a = s[3];
        return __builtin_amdgcn_rsqf(((a[0] + a[1]) + (a[2] + a[3])) * (1.0f / KVRANK) + EPS);
    }
    __device__ __forceinline__ void operator()(float rs, int row, int col, f32x4 v) const {
        if (mode == 0) {
            const int c32 = __builtin_amdgcn_readfirstlane(col >> 5), h = c32 / 6, w32 = c32 - 6 * h;
            if (w32 >= 4) v = rope4(ROPE, (unsigned)row & (SEQ - 1), (unsigned)(col - h * 192 - 128), v);
            st_bf4(QB, (unsigned)row * NQB + (unsigned)col, v * rs);
        } else {
            const int c128 = __builtin_amdgcn_readfirstlane(col >> 7), h = c128 >> 1;
            const unsigned off = (unsigned)row * 1024u + (unsigned)(h * 128 + (col & 127));
            if ((c128 & 1) == 0) st_bf4(KN, off, v * rs); else st_bf4(VB, off, v * rs);
        }
    }
};
struct EpiRes {
    static constexpr bool HAS_SLOTS = false;
    const float* base; float* out; const float* gate;
    __device__ __forceinline__ bool tile_has_slots(int) const { return false; }
    __device__ __forceinline__ void slot_store(int, int, float) const {}
    __device__ __forceinline__ int row_ctx(int row) const { return __builtin_amdgcn_readfirstlane(row / SEQ); }
    __device__ __forceinline__ void operator()(int b, int row, int col, f32x4 v) const {
        const unsigned off = (unsigned)row * DM + (unsigned)col;
        const f32x4 g = *(const GAS f32x4*)(gate + b * MOD_N + col), x0 = *(const GAS f32x4*)(base + off);
        *(GAS f32x4*)(out + off) = x0 + g * v;
    }
};
struct EpiRelu2 {
    static constexpr bool HAS_SLOTS = false;
    bf16* H;
    __device__ __forceinline__ bool tile_has_slots(int) const { return false; }
    __device__ __forceinline__ void slot_store(int, int, float) const {}
    __device__ __forceinline__ NoCtx row_ctx(int) const { return NoCtx{}; }
    __device__ __forceinline__ void operator()(NoCtx, int row, int col, f32x4 v) const {
        f32x4 u;
#pragma unroll
        for (int e = 0; e < 4; ++e) { const float t = fmaxf(v[e], 0.f); u[e] = t * t; }
        st_bf4(H, (unsigned)row * FF + (unsigned)col, u);
    }
};

template <class Fn> __device__ __forceinline__ void naive_gemm(Frame& F, const bf16* A, const bf16* Bt, int Mr, int N, int K, const Fn& f) {
    const int gw = F.vcu * NWAVES + F.wave, NGW = F.G * NWAVES, fr = F.lane & 15, fq = F.lane >> 4;
    const int tn = N / 32, ntiles = (Mr / 32) * tn;
    for (int t = gw; t < ntiles; t += NGW) {
        const int row0 = (t / tn) * 32, col0 = (t % tn) * 32;
        f32x4 acc[2][2];
#pragma unroll
        for (int a = 0; a < 2; ++a)
#pragma unroll
            for (int b = 0; b < 2; ++b) acc[a][b] = (f32x4){0.f, 0.f, 0.f, 0.f};
        for (int k = 0; k < K; k += 32) {
            bf16x8 a[2], b[2];
#pragma unroll
            for (int i = 0; i < 2; ++i) { a[i] = *(const GAS bf16x8*)(A + (size_t)(row0 + 16 * i + fr) * K + k + 8 * fq); b[i] = *(const GAS bf16x8*)(Bt + (size_t)(col0 + 16 * i + fr) * K + k + 8 * fq); }
#pragma unroll
            for (int mi = 0; mi < 2; ++mi)
#pragma unroll
                for (int ni = 0; ni < 2; ++ni) acc[mi][ni] = __builtin_amdgcn_mfma_f32_16x16x32_bf16(b[ni], a[mi], acc[mi][ni], 0, 0, 0);
        }
#pragma unroll
        for (int mi = 0; mi < 2; ++mi) { const int row = row0 + 16 * mi + fr; const auto rc = f.row_ctx(row);
#pragma unroll
            for (int ni = 0; ni < 2; ++ni) f(rc, row, col0 + 16 * ni + 4 * fq, acc[mi][ni]); }
    }
}

__device__ __forceinline__ void naive_swa(Frame& F) {
    const int gw = F.vcu * NWAVES + F.wave, NGW = F.G * NWAVES, lane = F.lane;
    for (int t = gw; t < NB * 16 * SEQ; t += NGW) {
        const int pos = t % SEQ, head = (t / SEQ) % 16, b = t / (SEQ * 16), hk = head >> 3;
        const size_t row = (size_t)b * SEQ + pos;
        const bf16* q = WSP(bf16, WS_QA) + row * 1024 + head * 64;
        float sc[2];
#pragma unroll
        for (int u = 0; u < 2; ++u) {
            const int kp = pos - 127 + lane + 64 * u; float s = -INFINITY;
            if (kp >= 0) { const bf16* kr = WSP(bf16, WS_KA) + ((size_t)b * SEQ + kp) * 128 + hk * 64; float a = 0.f;
                for (int d = 0; d < 64; d += 8) { const bf16x8 kv = *(const GAS bf16x8*)(kr + d), qv = *(const GAS bf16x8*)(q + d);
#pragma unroll
                    for (int e = 0; e < 8; ++e) a += bf2f((unsigned short)kv[e]) * bf2f((unsigned short)qv[e]); }
                s = a + WSP(float, WS_BIAS)[head * 128 + (pos - kp)]; }
            sc[u] = s;
        }
        const float sink = in_ptr(F, 6)[head] * LOG2E;
        const float m = fmaxf(wave_max(fmaxf(sc[0], sc[1])), sink);
        const float p0 = __builtin_amdgcn_exp2f(sc[0] - m), p1 = __builtin_amdgcn_exp2f(sc[1] - m);
        const float l = wave_sum(p0 + p1) + __builtin_amdgcn_exp2f(sink - m);
        float o = 0.f;
        for (int kk = 0; kk < 128; ++kk) { const float pk = __shfl(kk < 64 ? p0 : p1, kk & 63); const int kp = pos - 127 + kk;
            if (kp >= 0) o += pk * bf2f(WSP(bf16, WS_VA)[((size_t)b * SEQ + kp) * 128 + hk * 64 + lane]); }
        WSP(bf16, WS_MIX)[row * DM + head * 64 + lane] = (bf16)f2bf(o / l);
    }
}
__device__ __forceinline__ void naive_mla(Frame& F) {
    const int gw = F.vcu * NWAVES + F.wave, NGW = F.G * NWAVES, lane = F.lane;
    LAS float* sc = (LAS float*)(F.lds + RING_OFF) + F.wave * 4096;
    LAS float* qf = (LAS float*)(F.lds + LDS_EXTRA_OFF) + F.wave * 192;
    for (int t = gw; t < NB * 8 * (SEQ / 2); t += NGW) {
        const int j = t % (SEQ / 2), bh = t / (SEQ / 2), b = bh >> 3, h = bh & 7;
        for (int pass = 0; pass < 2; ++pass) {
            const int pos = pass ? SEQ - 1 - j : j; const size_t row = (size_t)b * SEQ + pos;
            for (int d = lane; d < 192; d += 64) qf[d] = bf2f(WSP(bf16, WS_QB)[row * NQB + h * 192 + d]);
            LDS_WAIT(); asm volatile("" ::: "memory");
            float mx = -INFINITY;
            for (int kp = lane; kp <= pos; kp += 64) {
                const size_t kr = (size_t)b * SEQ + kp; float a = 0.f;
                for (int d = 0; d < 128; d += 8) { const bf16x8 kv = *(const GAS bf16x8*)(WSP(bf16, WS_KN) + kr * 1024 + h * 128 + d);
#pragma unroll
                    for (int e = 0; e < 8; ++e) a += bf2f((unsigned short)kv[e]) * qf[d + e]; }
                for (int d = 0; d < 64; d += 8) { const bf16x8 kv = *(const GAS bf16x8*)(WSP(bf16, WS_KR) + kr * 64 + d);
#pragma unroll
                    for (int e = 0; e < 8; ++e) a += bf2f((unsigned short)kv[e]) * qf[128 + d + e]; }
                sc[kp] = a; mx = fmaxf(mx, a);
            }
            mx = wave_max(mx);
            float ls = 0.f;
            for (int kp = lane; kp <= pos; kp += 64) { const float p = __builtin_amdgcn_exp2f(sc[kp] - mx); sc[kp] = p; ls += p; }
            ls = wave_sum(ls);
            LDS_WAIT(); asm volatile("" ::: "memory");
            float o0 = 0.f, o1 = 0.f;
            for (int kp = 0; kp <= pos; ++kp) { const float p = sc[kp]; const unsigned vv = *(const GAS unsigned*)(WSP(bf16, WS_VB) + ((size_t)b * SEQ + kp) * 1024 + h * 128 + 2 * lane);
                o0 += p * bf2f(vv & 0xffffu); o1 += p * bf2f(vv >> 16); }
            *(GAS unsigned*)(WSP(bf16, WS_MIX) + row * DM + 1024 + h * 128 + 2 * lane) = pk2(o0 / ls, o1 / ls);
            LDS_WAIT(); asm volatile("" ::: "memory");
        }
    }
}

namespace att {
typedef short s16x4 __attribute__((ext_vector_type(4)));
typedef float f32x16 __attribute__((ext_vector_type(16)));
typedef LAS char* lptr;
#define SBAR() __builtin_amdgcn_sched_barrier(0)
__device__ __forceinline__ int crow(int r, int hi) { return (r & 3) + 8 * (r >> 2) + 4 * hi; }
__device__ __forceinline__ unsigned cvtpk(float lo, float hi) { unsigned r; asm volatile("v_cvt_pk_bf16_f32 %0, %1, %2" : "=v"(r) : "v"(lo), "v"(hi)); return r; }
template <int NCB> __device__ __forceinline__ int v_st(int k, int c) { const int kk = (k & ~0xC) | ((k & 4) << 1) | ((k & 8) >> 1); return ((kk >> 3) * NCB + (c >> 5)) * 512 + ((kk & 7) * 32 + (c & 31)) * 2; }
__device__ __forceinline__ int v_rd_base(int lane) { return ((lane & 3) << 3) | (((lane >> 2) & 3) << 6) | (((lane >> 4) & 1) << 5) | (((lane >> 5) & 1) << 8); }
#define PK4(P, B_, OUT) do { unsigned a0 = cvtpk(P[B_+0], P[B_+1]), a1 = cvtpk(P[B_+2], P[B_+3]); unsigned b0 = cvtpk(P[B_+4], P[B_+5]), b1 = cvtpk(P[B_+6], P[B_+7]); \
        auto r0 = __builtin_amdgcn_permlane32_swap(a0, b0, false, false); auto r1 = __builtin_amdgcn_permlane32_swap(a1, b1, false, false); \
        v4u w = {r0[0], r1[0], r0[1], r1[1]}; OUT = __builtin_bit_cast(bf16x8, w); } while (0)
#define TRRD(dst, base, off) asm volatile("ds_read_b64_tr_b16 %0, %1 offset:%2" : "=&v"(dst) : "v"(base), "i"(off) : "memory")
#define BF8(l, h) ((bf16x8){l[0], l[1], l[2], l[3], h[0], h[1], h[2], h[3]})

constexpr int QBLK = 32, KVBLK = 64, QB = 256;
constexpr int SHM_V = KVBLK * 128 * 2, SHM_KN = KVBLK * 128 * 2, SHM_KR = KVBLK * 64 * 2, SHM_K = SHM_KN + SHM_KR;
constexpr int MLA_QR = 2 * SHM_V + 2 * SHM_K + NWAVES * 64 * 4;
constexpr int MLA_LDS = MLA_QR + QB * 64 * 2;
constexpr float THR = 8.f;
#define KSWZ(row, colB) ((row) * 256 + ((colB) ^ (((row) & 7) << 4)))
__device__ __forceinline__ void mask_causal(f32x16& p0, f32x16& p1, int dq) {
    const float NEG = -__builtin_inff();
#pragma unroll
    for (int r = 0; r < 16; ++r) { const int c = (r & 3) + 8 * (r >> 2); if (dq - c < 0) p0[r] = NEG; if (dq - c - 32 < 0) p1[r] = NEG; }
}
__device__ __forceinline__ void partialSM(f32x16& p0, f32x16& p1, float& m_reg, float& mn, float& alpha) {
    float pmax = p0[0];
#pragma unroll
    for (int r = 1; r < 16; ++r) pmax = fmaxf(pmax, p0[r]);
#pragma unroll
    for (int r = 0; r < 16; ++r) pmax = fmaxf(pmax, p1[r]);
    { auto rr = __builtin_amdgcn_permlane32_swap(__float_as_uint(pmax), __float_as_uint(pmax), false, false); pmax = fmaxf(__uint_as_float(rr[0]), __uint_as_float(rr[1])); }
    if (__builtin_expect(__all(pmax - m_reg <= THR), 1)) { mn = m_reg; alpha = 1.f; }
    else { mn = fmaxf(m_reg, pmax); alpha = __builtin_amdgcn_exp2f(m_reg - mn); m_reg = mn; }
#pragma unroll
    for (int r = 0; r < 16; ++r) p0[r] -= mn;
#pragma unroll
    for (int r = 0; r < 16; ++r) p1[r] -= mn;
#pragma unroll
    for (int r = 0; r < 16; ++r) p0[r] = __builtin_amdgcn_exp2f(p0[r]);
}
__device__ __forceinline__ void finishSM(f32x16& p0, f32x16& p1, float alpha, float& l_reg, bf16x8& pa0, bf16x8& pa1, bf16x8& pa2, bf16x8& pa3) {
#pragma unroll
    for (int r = 0; r < 16; ++r) p1[r] = __builtin_amdgcn_exp2f(p1[r]);
    float ps = 0;
#pragma unroll
    for (int r = 0; r < 16; ++r) ps += p0[r];
#pragma unroll
    for (int r = 0; r < 16; ++r) ps += p1[r];
    { auto rr = __builtin_amdgcn_permlane32_swap(__float_as_uint(ps), __float_as_uint(ps), false, false); ps = __uint_as_float(rr[0]) + __uint_as_float(rr[1]); }
    l_reg = l_reg * alpha + ps;
    PK4(p0, 0, pa0); PK4(p0, 8, pa1); PK4(p1, 0, pa2); PK4(p1, 8, pa3);
}
template <int KB> __device__ __forceinline__ void qkt(f32x16& p0, f32x16& p1, lptr K_lds, int r32, int hi, const bf16x8* qr, lptr qrl) {
    p0 = f32x16{}; p1 = f32x16{};
    lptr kb[4];
#pragma unroll
    for (int dd = 0; dd < 4; ++dd) kb[dd] = K_lds + KB * SHM_K + KSWZ(r32, (dd * 16 + hi * 8) * 2);
#pragma unroll
    for (int d0 = 0; d0 < 8; ++d0) { lptr a = kb[d0 & 3] + (d0 >> 2) * 128;
        const bf16x8 b0 = *(const LAS bf16x8*)a, b1 = *(const LAS bf16x8*)(a + 32 * 256);
        p0 = __builtin_amdgcn_mfma_f32_32x32x16_bf16(b0, qr[d0], p0, 0, 0, 0);
        p1 = __builtin_amdgcn_mfma_f32_32x32x16_bf16(b1, qr[d0], p1, 0, 0, 0); }
    lptr kr = K_lds + KB * SHM_K + SHM_KN + r32 * 128;
#pragma unroll
    for (int d1 = 0; d1 < 4; ++d1) { lptr a = kr + (((2 * d1 + hi) ^ (r32 & 7)) << 4);
        const bf16x8 b0 = *(const LAS bf16x8*)a, b1 = *(const LAS bf16x8*)(a + 32 * 128), qv = *(const LAS bf16x8*)(qrl + (((2 * d1 + hi) ^ (r32 & 7)) << 4));
        p0 = __builtin_amdgcn_mfma_f32_32x32x16_bf16(b0, qv, p0, 0, 0, 0);
        p1 = __builtin_amdgcn_mfma_f32_32x32x16_bf16(b1, qv, p1, 0, 0, 0); }
}
template <int VB> __device__ __forceinline__ void pv_tile(f32x16* o, int vb0, bf16x8 pa0, bf16x8 pa1, bf16x8 pa2, bf16x8 pa3) {
#define PV_D0(d0) do { s16x4 l0, l1, l2, l3, h0, h1, h2, h3; constexpr int b_ = VB * SHM_V + (d0) * 512; \
        TRRD(l0, vb0, b_); TRRD(h0, vb0, b_ + 2048); TRRD(l1, vb0, b_ + 4096); TRRD(h1, vb0, b_ + 6144); TRRD(l2, vb0, b_ + 8192); TRRD(h2, vb0, b_ + 10240); TRRD(l3, vb0, b_ + 12288); TRRD(h3, vb0, b_ + 14336); \
        asm volatile("s_waitcnt lgkmcnt(0)" ::: "memory"); SBAR(); \
        o[d0] = __builtin_amdgcn_mfma_f32_32x32x16_bf16(pa0, BF8(l0, h0), o[d0], 0, 0, 0); \
        o[d0] = __builtin_amdgcn_mfma_f32_32x32x16_bf16(pa1, BF8(l1, h1), o[d0], 0, 0, 0); \
        o[d0] = __builtin_amdgcn_mfma_f32_32x32x16_bf16(pa2, BF8(l2, h2), o[d0], 0, 0, 0); \
        o[d0] = __builtin_amdgcn_mfma_f32_32x32x16_bf16(pa3, BF8(l3, h3), o[d0], 0, 0, 0); } while (0)
    PV_D0(0); PV_D0(1); PV_D0(2); PV_D0(3);
#undef PV_D0
}
__device__ __forceinline__ void mla_unit(const bf16* Qp, const bf16* KNp, const bf16* KRp, const bf16* Vp, bf16* Op, int q0, lptr lds) {
    int tid_ = threadIdx.x; asm volatile("" : "+v"(tid_));
    const int tid = tid_, wid = __builtin_amdgcn_readfirstlane(tid >> 6), lane = tid & 63, r32 = lane & 31, hi = lane >> 5;
    const int NT = (q0 + QB) / KVBLK;
    const int qlo = q0 + wid * QBLK, qm = qlo + r32 - 4 * hi;
    lptr V_lds = lds; lptr K_lds = lds + 2 * SHM_V;
    LAS float* ws = (LAS float*)(lds + 2 * SHM_V + 2 * SHM_K) + wid * 64; LAS float* li_l = ws; LAS float* al_l = ws + 32;
    float m_reg = -1e30f, l_reg = 0; f32x16 o[4] = {};
    const int sr = tid >> 4, sc = (tid & 15) * 8, vst0 = v_st<4>(sr, sc), vst1 = v_st<4>(32 + sr, sc), kws = KSWZ(sr, sc * 2);
    const int rr = tid >> 3, rc = (tid & 7) * 8, krs = SHM_KN + rr * 128 + ((rc * 2) ^ ((rr & 7) << 4));
    const int vb0 = (int)(unsigned)(uintptr_t)V_lds + v_rd_base(lane);
    bf16x8 qr[8];
#pragma unroll
    for (int d0 = 0; d0 < 8; ++d0) qr[d0] = *(const GAS bf16x8*)(Qp + (unsigned)((wid * QBLK + r32) * NQB + d0 * 16 + hi * 8));
    lptr qrl = lds + MLA_QR + (wid * QBLK + r32) * 128;
#pragma unroll
    for (int d1 = 0; d1 < 4; ++d1) *(LAS bf16x8*)(qrl + (((2 * d1 + hi) ^ (r32 & 7)) << 4)) = *(const GAS bf16x8*)(Qp + (unsigned)((wid * QBLK + r32) * NQB + 128 + d1 * 16 + hi * 8));
    bf16x8 st_v0, st_v1, st_k0, st_k1, st_k2;
#define VMW() asm volatile("s_waitcnt vmcnt(0)" ::: "memory")
#define SLOAD(k0) do { st_v0 = *(const GAS bf16x8*)(Vp + (unsigned)(((k0) + sr) * 1024 + sc)); st_v1 = *(const GAS bf16x8*)(Vp + (unsigned)(((k0) + 32 + sr) * 1024 + sc)); \
        st_k0 = *(const GAS bf16x8*)(KNp + (unsigned)(((k0) + sr) * 1024 + sc)); st_k1 = *(const GAS bf16x8*)(KNp + (unsigned)(((k0) + 32 + sr) * 1024 + sc)); \
        st_k2 = *(const GAS bf16x8*)(KRp + (unsigned)(((k0) + rr) * 64 + rc)); } while (0)
#define SWRITE(bf) do { *(LAS bf16x8*)(V_lds + (bf) * SHM_V + vst0) = st_v0; *(LAS bf16x8*)(V_lds + (bf) * SHM_V + vst1) = st_v1; \
        *(LAS bf16x8*)(K_lds + (bf) * SHM_K + kws) = st_k0; *(LAS bf16x8*)(K_lds + (bf) * SHM_K + kws + 32 * 256) = st_k1; *(LAS bf16x8*)(K_lds + (bf) * SHM_K + krs) = st_k2; } while (0)
#define RESC(a) do { if (__any((a) < 1.f)) { if (hi == 0) al_l[r32] = (a); asm volatile("s_waitcnt lgkmcnt(0)" ::: "memory"); \
        _Pragma("unroll") for (int d_ = 0; d_ < 4; ++d_) _Pragma("unroll") for (int r = 0; r < 16; ++r) o[d_][r] *= al_l[crow(r, hi)]; } } while (0)
#define KBASE(t) ((t) * KVBLK)
#define MASKT(P0_, P1_, t) do { const int kb_ = KBASE(t); if (kb_ + KVBLK - 1 > qlo) mask_causal(P0_, P1_, qm - kb_); } while (0)
    f32x16 pA0, pA1; float mnA, alA; bf16x8 pa0, pa1, pa2, pa3;
    SLOAD(0); VMW(); SWRITE(0); SBAR();
    SLOAD(KBASE(1));
    __syncthreads();
    SBAR(); qkt<0>(pA0, pA1, K_lds, r32, hi, qr, qrl);
    MASKT(pA0, pA1, 0); partialSM(pA0, pA1, m_reg, mnA, alA);
    VMW(); SWRITE(1);
    __syncthreads();
#define HALF_STEP(t, KB, VB, SB) do { \
        SBAR(); finishSM(pA0, pA1, alA, l_reg, pa0, pa1, pa2, pa3); SBAR(); \
        qkt<KB>(pA0, pA1, K_lds, r32, hi, qr, qrl); SBAR(); \
        SLOAD(KBASE((t) + 1)); SBAR(); \
        pv_tile<VB>(o, vb0, pa0, pa1, pa2, pa3); MASKT(pA0, pA1, (t)); partialSM(pA0, pA1, m_reg, mnA, alA); \
        __syncthreads(); \
        VMW(); SWRITE(SB); \
        RESC(alA); __syncthreads(); } while (0)
    for (int t = 1; t + 1 < NT; t += 2) {
        HALF_STEP(t, 1, 0, 0);
        HALF_STEP(t + 1, 0, 1, 1);
    }
    SBAR(); finishSM(pA0, pA1, alA, l_reg, pa0, pa1, pa2, pa3); SBAR();
    qkt<1>(pA0, pA1, K_lds, r32, hi, qr, qrl); SBAR();
    pv_tile<0>(o, vb0, pa0, pa1, pa2, pa3);
    MASKT(pA0, pA1, NT - 1); partialSM(pA0, pA1, m_reg, mnA, alA); __syncthreads(); RESC(alA);
    finishSM(pA0, pA1, alA, l_reg, pa0, pa1, pa2, pa3); SBAR(); pv_tile<1>(o, vb0, pa0, pa1, pa2, pa3);
    if (hi == 0) li_l[r32] = l_reg;
    __syncthreads();
    { int r32e = r32, hie = hi, lane_e = lane; asm volatile("" : "+v"(r32e), "+v"(hie), "+v"(lane_e));
      LAS bf16* stg = (LAS bf16*)lds + wid * 4096;
#pragma unroll
      for (int r = 0; r < 16; ++r) { const int orow = crow(r, hie); const float rl = __builtin_amdgcn_rcpf(li_l[orow]);
#pragma unroll
          for (int d0 = 0; d0 < 4; ++d0) stg[orow * 128 + d0 * 32 + r32e] = (bf16)f2bf(o[d0][r] * rl); }
      asm volatile("s_waitcnt lgkmcnt(0)" ::: "memory");
      bf16* Ow = Op + (unsigned)(wid * QBLK) * DM;
      const int lr = lane_e >> 4, lc = (lane_e & 15) * 8;
#pragma unroll
      for (int i = 0; i < 8; ++i) { const int row = i * 4 + lr; const v4u v = *(const LAS v4u*)(stg + row * 128 + lc); *(GAS v4u*)(Ow + (unsigned)(row * DM + lc)) = v; } }
    __syncthreads();
#undef VMW
#undef SLOAD
#undef SWRITE
#undef RESC
#undef KBASE
#undef MASKT
#undef HALF_STEP
}

constexpr int SWA_K = 0, SWA_V = 32768, SWA_B = 65536, SWA_L = SWA_B + NWAVES * 512, SWA_LDS = SWA_L + NWAVES * 128;
__device__ __forceinline__ void swa_unit(const bf16* QA, const bf16* KA, const bf16* VA, const float* BIAS, const float* sinks, bf16* MIX, int b, int hk, int n, lptr lds) {
    const int tid = threadIdx.x, wid = __builtin_amdgcn_readfirstlane(tid >> 6), lane = tid & 63, r32 = lane & 31, hi = lane >> 5;
    const int head = hk * 8 + wid;
    lptr K_lds = lds + SWA_K; lptr V_lds = lds + SWA_V;
    LAS float* bl = (LAS float*)(lds + SWA_B) + wid * 128; LAS float* ll = (LAS float*)(lds + SWA_L) + wid * 32;
#pragma unroll
    for (int i = 0; i < 4; ++i) { const int idx = tid + 512 * i, row = idx >> 3, ch = idx & 7, kpos = 128 * (n - 1) + row;
        bf16x8 kv = {0, 0, 0, 0, 0, 0, 0, 0}, vv = {0, 0, 0, 0, 0, 0, 0, 0};
        if (kpos >= 0) { const unsigned off = (unsigned)((b * SEQ + kpos) * 128 + hk * 64 + ch * 8); kv = *(const GAS bf16x8*)(KA + off); vv = *(const GAS bf16x8*)(VA + off); }
        *(LAS bf16x8*)(K_lds + row * 128 + ((ch ^ (row & 7)) << 4)) = kv;
        *(LAS bf16x8*)(V_lds + v_st<2>(row, ch * 8)) = vv; }
    bl[lane] = BIAS[head * 128 + lane]; bl[lane + 64] = BIAS[head * 128 + lane + 64];
    __syncthreads();
    const float sink2 = sinks[head] * LOG2E;
    const int vb = (int)(unsigned)(uintptr_t)V_lds + v_rd_base(lane);
    const float NEG = -__builtin_inff();
    for (int i = 0; i < 4; ++i) {
        const bf16* qrow = QA + (unsigned)((b * SEQ + 128 * n + 32 * i + r32) * 1024 + head * 64 + hi * 8);
        bf16x8 qr[4];
#pragma unroll
        for (int d0 = 0; d0 < 4; ++d0) qr[d0] = *(const GAS bf16x8*)(qrow + d0 * 16);
        f32x16 p[5];
#pragma unroll
        for (int jj = 0; jj < 5; ++jj) { p[jj] = f32x16{}; const int krow = 32 * (i + jj) + r32; lptr kr = K_lds + krow * 128;
#pragma unroll
            for (int d0 = 0; d0 < 4; ++d0) { const bf16x8 a = *(const LAS bf16x8*)(kr + (((2 * d0 + hi) ^ (krow & 7)) << 4)); p[jj] = __builtin_amdgcn_mfma_f32_32x32x16_bf16(a, qr[d0], p[jj], 0, 0, 0); } }
        float mx = sink2;
#pragma unroll
        for (int jj = 0; jj < 5; ++jj) { const bool kvalid = (n > 0) || (i + jj >= 4);
#pragma unroll
            for (int r = 0; r < 16; ++r) { const int dist = 128 + r32 - 32 * jj - crow(r, hi); const bool ok = kvalid && dist >= 0 && dist < 128;
                const float s = ok ? p[jj][r] + bl[dist & 127] : NEG; p[jj][r] = s; mx = fmaxf(mx, s); } }
        { auto rr_ = __builtin_amdgcn_permlane32_swap(__float_as_uint(mx), __float_as_uint(mx), false, false); mx = fmaxf(__uint_as_float(rr_[0]), __uint_as_float(rr_[1])); }
        float ls = 0.f;
#pragma unroll
        for (int jj = 0; jj < 5; ++jj)
#pragma unroll
            for (int r = 0; r < 16; ++r) { const float e = __builtin_amdgcn_exp2f(p[jj][r] - mx); p[jj][r] = e; ls += e; }
        { auto rr_ = __builtin_amdgcn_permlane32_swap(__float_as_uint(ls), __float_as_uint(ls), false, false); ls = __uint_as_float(rr_[0]) + __uint_as_float(rr_[1]); }
        ls += __builtin_amdgcn_exp2f(sink2 - mx);
        if (hi == 0) ll[r32] = ls;
        bf16x8 pa[10];
#pragma unroll
        for (int jj = 0; jj < 5; ++jj) { PK4(p[jj], 0, pa[2 * jj]); PK4(p[jj], 8, pa[2 * jj + 1]); }
        f32x16 o[2] = {};
        const int vbi = vb + i * 4096;
#pragma unroll
        for (int ks = 0; ks < 10; ++ks)
#pragma unroll
            for (int d0 = 0; d0 < 2; ++d0) { s16x4 l_, h_; TRRD(l_, vbi, d0 * 512 + ks * 2048); TRRD(h_, vbi, d0 * 512 + ks * 2048 + 1024);
                asm volatile("s_waitcnt lgkmcnt(0)" ::: "memory"); SBAR();
                o[d0] = __builtin_amdgcn_mfma_f32_32x32x16_bf16(pa[ks], BF8(l_, h_), o[d0], 0, 0, 0); }
        asm volatile("s_waitcnt lgkmcnt(0)" ::: "memory");
        bf16* Ow = MIX + (unsigned)((b * SEQ + 128 * n + 32 * i) * DM + head * 64);
#pragma unroll
        for (int r = 0; r < 16; ++r) { const int orow = crow(r, hi); const float rl = __builtin_amdgcn_rcpf(ll[orow]);
#pragma unroll
            for (int d0 = 0; d0 < 2; ++d0) { const float v = o[d0][r] * rl; const float vn = __shfl_xor(v, 1);
                if ((r32 & 1) == 0) *(GAS unsigned*)(Ow + (unsigned)(orow * DM + d0 * 32 + r32)) = cvtpk(v, vn); } }
        asm volatile("s_waitcnt lgkmcnt(0)" ::: "memory");
    }
    __syncthreads();
}
#undef SBAR
#undef KSWZ
}

__device__ __forceinline__ void attn_phase(Frame& F) {
    att::lptr lds = (att::lptr)(F.lds + RING_OFF);
    const float* sinks = in_ptr(F, 6);
#if !NAIVE_SWA
    { const int b = F.vcu >> 6, hk = (F.vcu >> 5) & 1, n = F.vcu & 31;
      att::swa_unit(WSP(bf16, WS_QA), WSP(bf16, WS_KA), WSP(bf16, WS_VA), WSP(float, WS_BIAS), sinks, WSP(bf16, WS_MIX), b, hk, n, lds); }
#endif
#if !NAIVE_MLA
    { const int bh = F.vcu >> 3, s = F.vcu & 7, b = bh >> 3, h = bh & 7;
      for (int pass = 0; pass < 2; ++pass) { const int qb = pass ? 15 - s : s, q0 = qb * att::QB;
          att::mla_unit(WSP(bf16, WS_QB) + (size_t)(b * SEQ + q0) * NQB + h * 192, WSP(bf16, WS_KN) + (size_t)b * SEQ * 1024 + h * 128, WSP(bf16, WS_KR) + (size_t)b * SEQ * 64,
                        WSP(bf16, WS_VB) + (size_t)b * SEQ * 1024 + h * 128, WSP(bf16, WS_MIX) + (size_t)(b * SEQ + q0) * DM + 1024 + h * 128, q0, lds); } }
#endif
}

struct Args { const float* in[17]; float* out; unsigned char* ws; int ph_lo, ph_hi, li, pad; };
__global__ void __launch_bounds__(NWAVES * 64, 2) hymba_fwd(Args args) {
    extern __shared__ __attribute__((aligned(16))) unsigned char lds[];
    Frame F;
    F.lds = (LAS unsigned char*)lds;
    F.MISC = (volatile LAS unsigned*)(F.lds + MISC_OFF);
    F.tid = threadIdx.x; F.lane = F.tid & 63; F.wave = __builtin_amdgcn_readfirstlane(F.tid >> 6);
    F.G = gridDim.x; { const int bx = blockIdx.x; F.vcu = (F.G % 8 == 0) ? (bx % 8) * (F.G / 8) + bx / 8 : bx; }
    unsigned char* ws = args.ws;
    F.ctl = (gu32*)(ws + WS_CTL);
    F.out = args.out; F.ws = ws;
    for (int u = F.tid; u < (LDS_EXTRA_OFF - LDSCTL_OFF) / 4; u += NWAVES * 64) ((LAS unsigned*)(F.lds + LDSCTL_OFF))[u] = 0u;
    __syncthreads();
    if (F.tid == 0) { LAS unsigned long long* t = (LAS unsigned long long*)(F.lds + INPTR_OFF);
#pragma unroll
        for (int k = 0; k < 17; ++k) t[k] = (unsigned long long)(uintptr_t)args.in[k]; }
    __syncthreads();
    XcdBarrier bar; bar.bar = (unsigned*)(F.ctl + CW_BAR); bar.x = 0; bar.st = nullptr;
    if (N_LAUNCHES != PER_PHASE) bar = xcd_barrier_post((unsigned*)(F.ctl + CW_BAR), F.MISC + 8);
#define GRID_BAR(seam) do { if (N_LAUNCHES == PER_PHASE) { if (F.tid == 0) __hip_atomic_store(F.ctl + CW_TMO, 0xBADBA0u | (unsigned)(seam), RLX_AGENT); } else { xcd_barrier(bar); } } while (0)
    const int lo = args.ph_lo, hi = args.ph_hi;
#ifndef ONLY_PHASE
#define ONLY_PHASE -1
#endif
#define IN(k) ((ONLY_PHASE < 0 || ONLY_PHASE == (k)) && lo <= (k) && (k) < hi)
#define BOTH(k) (IN(k) && IN((k) + 1))
    const bool grid_ok = (F.G == 256);

    if (IN(0)) { p0_prologue(F); if (BOTH(0)) GRID_BAR(0); }
    if (IN(1)) { if (grid_ok) norm_mod_phase<true>(F, in_ptr(F, 0), in_ptr(F, 4), 0, 1); __syncthreads(); if (BOTH(1)) GRID_BAR(1); }
    if (IN(2)) {
#if NAIVE_GEMM
        EpiIn<true> f{WSP(bf16, WS_QA), WSP(bf16, WS_KA), WSP(bf16, WS_VA), WSP(bf16, WS_CQ), WSP(bf16, WS_CKV), WSP(bf16, WS_KR), WSP(float, WS_SSQ), WSP(float, WS_ROPE)};
        naive_gemm(F, WSP(bf16, WS_XN), WSP(bf16, WS_WIN), M, IN_PAD, DM, f);
#else
        pg8::Gemm g{WSP(bf16, WS_XN), WSP(bf16, WS_WIN), M, IN_PAD, DM}; pg8::StaticOrder S; S.init(M, IN_PAD, F.G, (int)blockIdx.x);
        pg8::EpiRow<EpiIn<false>> E{{WSP(bf16, WS_QA), WSP(bf16, WS_KA), WSP(bf16, WS_VA), WSP(bf16, WS_CQ), WSP(bf16, WS_CKV), WSP(bf16, WS_KR), WSP(float, WS_SSQ), WSP(float, WS_ROPE)}};
        pg8::gemm_phase<pg8::EpiRow<EpiIn<false>>, pg8::StaticOrder, PG8_ALIGN, PG8_SP2>(F.lds + RING_OFF, g, S, E);
#endif
        if (BOTH(2)) GRID_BAR(2);
    }
    if (IN(3)) {
        for (int gi = 0; gi < 2; ++gi) {
            EpiUp f{WSP(bf16, WS_QB), WSP(bf16, WS_KN), WSP(bf16, WS_VB), WSP(float, WS_SSQ), WSP(float, WS_ROPE), gi};
            const bf16* A = gi ? WSP(bf16, WS_CKV) : WSP(bf16, WS_CQ); const bf16* Bt = gi ? WSP(bf16, WS_WUKV) : WSP(bf16, WS_WUQ);
            const int N = gi ? NKVB : NQB, K = gi ? KVRANK : QRANK;
#if NAIVE_GEMM
            naive_gemm(F, A, Bt, M, N, K, f);
#else
            pg8::Gemm g{A, Bt, M, N, K}; pg8::StaticOrder S; S.init(M, N, F.G, (int)blockIdx.x);
            pg8::EpiRow<EpiUp> E{f}; pg8::gemm_phase<pg8::EpiRow<EpiUp>, pg8::StaticOrder, PG8_ALIGN, PG8_SP2>(F.lds + RING_OFF, g, S, E);
#endif
        }
        if (BOTH(3)) GRID_BAR(3);
    }
    if (IN(4)) {
#if NAIVE_SWA
        naive_swa(F);
#endif
#if NAIVE_MLA
        naive_mla(F);
#endif
        __syncthreads();
        if (grid_ok) attn_phase(F);
        if (BOTH(4)) GRID_BAR(4);
    }
    if (IN(5)) {
        EpiRes f{in_ptr(F, 0), F.out, WSP(float, WS_MOD) + 2 * DM};
#if NAIVE_GEMM
        naive_gemm(F, WSP(bf16, WS_MIX), WSP(bf16, WS_WOUT), M, DM, DM, f);
#else
        pg8::Gemm g{WSP(bf16, WS_MIX), WSP(bf16, WS_WOUT), M, DM, DM}; pg8::StaticOrder S; S.init(M, DM, F.G, (int)blockIdx.x);
        pg8::EpiRow<EpiRes> E{f}; pg8::gemm_phase<pg8::EpiRow<EpiRes>, pg8::StaticOrder, PG8_ALIGN, PG8_SP2>(F.lds + RING_OFF, g, S, E);
#endif
        if (BOTH(5)) GRID_BAR(5);
    }
    if (IN(6)) { if (grid_ok) norm_mod_phase<false>(F, F.out, in_ptr(F, 13), 3, 4); __syncthreads(); if (BOTH(6)) GRID_BAR(6); }
    if (IN(7)) {
        EpiRelu2 f{WSP(bf16, WS_H)};
#if NAIVE_GEMM
        naive_gemm(F, WSP(bf16, WS_XN), WSP(bf16, WS_W1), M, FF, DM, f);
#else
        pg8::Gemm g{WSP(bf16, WS_XN), WSP(bf16, WS_W1), M, FF, DM}; pg8::StaticOrder S; S.init(M, FF, F.G, (int)blockIdx.x);
        pg8::EpiRow<EpiRelu2> E{f}; pg8::gemm_phase<pg8::EpiRow<EpiRelu2>, pg8::StaticOrder, PG8_ALIGN, PG8_SP2>(F.lds + RING_OFF, g, S, E);
#endif
        if (BOTH(7)) GRID_BAR(7);
    }
    if (IN(8)) {
        EpiRes f{F.out, F.out, WSP(float, WS_MOD) + 5 * DM};
#if NAIVE_GEMM
        naive_gemm(F, WSP(bf16, WS_H), WSP(bf16, WS_W2), M, DM, FF, f);
#else
        pg8::Gemm g{WSP(bf16, WS_H), WSP(bf16, WS_W2), M, DM, FF}; pg8::StaticOrder S; S.init(M, DM, F.G, (int)blockIdx.x);
        pg8::EpiRow<EpiRes> E{f}; pg8::gemm_phase<pg8::EpiRow<EpiRes>, pg8::StaticOrder, PG8_ALIGN, PG8_SP2>(F.lds + RING_OFF, g, S, E);
#endif
        if (BOTH(8)) GRID_BAR(8);
    }
    if (IN(9)) {
        bool bad = !grid_ok || __hip_atomic_load(F.ctl + CW_TMO, RLX_AGENT) != 0u || __hip_atomic_load((gu32*)((unsigned*)(F.ctl + CW_BAR) + XB_TMO), RLX_AGENT) != 0u;
        if (bad) nan_rows_f32(F, F.out); else final_norm_phase(F);
    }
#undef IN
#undef BOTH
}

extern "C" void kernel_launch(void* const* d_in, const int* in_sizes, int n_in, void* d_out, int out_size, void* d_ws, size_t ws_size, hipStream_t stream) {
    static int grid = 0;
    if (grid == 0) {
        if (n_in != 17 || in_sizes[0] != M * DM || out_size != M * DM || ws_size < WS_END) { fprintf(stderr, "kernel_launch: shape mismatch (n_in %d, in0 %d, out %d, ws %zu)\n", n_in, n_in > 0 ? in_sizes[0] : -1, out_size, ws_size); grid = -1; return; }
        int dev = 0, cus = 0;
        if (hipGetDevice(&dev) != hipSuccess || hipDeviceGetAttribute(&cus, hipDeviceAttributeMultiprocessorCount, dev) != hipSuccess) { grid = -1; return; }
        if (hipFuncSetAttribute((const void*)hymba_fwd, hipFuncAttributeMaxDynamicSharedMemorySize, LDS_BYTES) != hipSuccess) { fprintf(stderr, "kernel_launch: hipFuncSetAttribute failed\n"); grid = -1; return; }
        (void)hipGetLastError();
        grid = cus;
        if (grid != 256) fprintf(stderr, "kernel_launch: %d CUs; this kernel is built for 256\n", grid);
    }
    if (grid < 0) return;
    if (hipMemsetAsync((char*)d_ws + WS_CTL, 0, CTL_ZERO_BYTES, stream) != hipSuccess) { fprintf(stderr, "kernel_launch: memset failed\n"); return; }
    Args a{};
    for (int i = 0; i < 17; ++i) a.in[i] = (const float*)d_in[i];
    a.out = (float*)d_out; a.ws = (unsigned char*)d_ws;
    for (int li = 0; li < N_LAUNCHES; ++li) {
        if (N_LAUNCHES == PER_PHASE) { a.ph_lo = li; a.ph_hi = li + 1; } else { a.ph_lo = 0; a.ph_hi = PER_PHASE; }
        a.li = li;
        hipLaunchKernelGGL(hymba_fwd, dim3(grid), dim3(NWAVES * 64), LDS_BYTES, stream, a);
        const hipError_t le = hipPeekAtLastError();
        if (le != hipSuccess) { fprintf(stderr, "kernel_launch: launch %d failed: %s\n", li, hipGetErrorName(le)); break; }
    }
}
```

```cpp
#include <hip/hip_runtime.h>
#include <cstdio>
#include <cstdint>

#ifndef MK_N_LAUNCHES
#define MK_N_LAUNCHES 1
#endif
#ifndef NAIVE_GEMM
#define NAIVE_GEMM 0
#endif
#ifndef NAIVE_SWA
#define NAIVE_SWA 0
#endif
#ifndef NAIVE_MLA
#define NAIVE_MLA 0
#endif

constexpr int NB = 4, SEQ = 4096, DM = 2048, M = NB * SEQ, FF = 8192;
constexpr int IN_COLS = 1856, IN_PAD = 2048;
constexpr int QRANK = 384, KVRANK = 128, NQB = 1536, NKVB = 2048;
constexpr float EPS = 1e-6f;
constexpr float LOG2E = 1.4426950408889634f;
constexpr float CA = 0.125f * LOG2E;
constexpr float C2M = 0.07216878364870322f * LOG2E;
constexpr int OFF_KA = 1024, OFF_VA = 1152, OFF_CQ = 1280, OFF_CKV = 1664, OFF_KR = 1792;

namespace pg8 {
#define PG8_LAS __attribute__((address_space(3)))
typedef unsigned short bf16_t;
typedef short bf16x8 __attribute__((ext_vector_type(8)));
typedef float f32x4 __attribute__((ext_vector_type(4)));
typedef unsigned u32x4 __attribute__((ext_vector_type(4)));
constexpr int BM = 256, BK = 64, HALF = 128, HTB = HALF * BK * 2, STAGE_BYTES = 8 * HTB, NXCD = 8, WGM = 8;

__host__ __device__ __forceinline__ int lds_byte(int r, int c) { const int st = (r >> 4) * 2 + (c >> 5), rr = r & 15, cc = c & 31, ob = rr * 64 + cc * 2; return st * 1024 + (ob ^ (((ob >> 9) & 1) << 5)); }
__host__ __device__ __forceinline__ void stage_rc(int b, int& R, int& C) { const int st = b / 1024, sb = b % 1024, swz = sb ^ (((sb >> 9) & 1) << 5); R = (st >> 1) * 16 + swz / 64; C = (st & 1) * 32 + (swz % 64) / 2; }
__host__ __device__ __forceinline__ int perm32(int rho) { const int n = rho >> 4, i = rho & 15; return 8 * (i >> 2) + 4 * n + (i & 3); }

struct Unit { int pm, pn; };
struct Gemm { const bf16_t* A; const bf16_t* Bt; int M, N, K; };

struct StaticOrder {
    int nM, nN, nwg, G, c;
    __host__ __device__ void init(int M_, int N_, int G_, int c_) { nM = M_ / BM; nN = N_ / BM; nwg = nM * nN; G = G_; c = c_; }
    __host__ __device__ bool next(int i, Unit& u) const {
        const long L = (long)i * G + c; if (L >= nwg) return false;
        int wgid = (int)L; { const int q = nwg / NXCD, r = nwg % NXCD, xcd = wgid % NXCD, off = wgid / NXCD; wgid = (xcd < r ? xcd * (q + 1) : r * (q + 1) + (xcd - r) * q) + off; }
        const int nig = WGM * nN, gid = wgid / nig, fm = gid * WGM, gsz = (nM - fm) < WGM ? (nM - fm) : WGM;
        u.pm = fm + ((wgid % nig) % gsz); u.pn = (wgid % nig) / gsz; return true;
    }
    __device__ __forceinline__ void a_ready(const Unit&) const {}
    __device__ __forceinline__ void done(const Unit&) const {}
};

__device__ __forceinline__ unsigned cvt_pk_bf16(float lo, float hi) { unsigned r; asm volatile("v_cvt_pk_bf16_f32 %0, %1, %2" : "=v"(r) : "v"(lo), "v"(hi)); return r; }

template <class F> struct EpiRow {
    static constexpr bool PERM = false, AFTER_DRAIN = false;
    F f;
    __device__ __forceinline__ void operator()(const f32x4 (&acc)[2][2][4][2], const Unit& u, int wr, int wc, int fr, int fq) const {
        asm volatile("" : "+v"(fr), "+v"(fq));
        const int colb = u.pn * BM + wc * 32 + 4 * fq;
        const bool slots = f.tile_has_slots(u.pn * BM);
#pragma unroll
        for (int ai = 0; ai < 2; ++ai)
#pragma unroll
            for (int m = 0; m < 4; ++m) {
                const int row = u.pm * BM + ai * HALF + wr * 64 + m * 16 + fr;
                const auto rc = f.row_ctx(row);
#pragma unroll
                for (int bj = 0; bj < 2; ++bj) {
#pragma unroll
                    for (int n = 0; n < 2; ++n) f(rc, row, colb + bj * HALF + n * 16, acc[ai][bj][m][n]);
                    if constexpr (F::HAS_SLOTS) {
                        if (slots) {
                            const f32x4 a = acc[ai][bj][m][0], b = acc[ai][bj][m][1];
                            float s = (a[0] * a[0] + a[1] * a[1]) + (a[2] * a[2] + a[3] * a[3]) + (b[0] * b[0] + b[1] * b[1]) + (b[2] * b[2] + b[3] * b[3]);
                            s += __shfl_xor(s, 16); s += __shfl_xor(s, 32);
                            if (fq == 0) f.slot_store(row, u.pn * BM + bj * HALF + wc * 32, s);
                        }
                    }
                }
                asm volatile("" ::: "memory");
            }
    }
};

template <class Epi, class Sched, bool ALIGN_EPI = false, bool SP2 = false>
__device__ __forceinline__ void gemm_phase(PG8_LAS unsigned char* lds, const Gemm g, const Sched& S, const Epi& E) {
    int tid_ = threadIdx.x; asm volatile("" : "+v"(tid_));
    const int tid = tid_, wid = __builtin_amdgcn_readfirstlane(tid >> 6), lane = tid & 63, wr = wid >> 2, wc = wid & 3, fr = lane & 15, fq = lane >> 4;
    const int K = g.K, nt = K / BK;
    unsigned voffA[2], voffB[2];
#pragma unroll
    for (int i = 0; i < 2; ++i) { int R, C; stage_rc(tid * 16 + i * 8192, R, C); const int Rb = Epi::PERM ? ((R & ~31) + perm32(R & 31)) : R;
        voffA[i] = (unsigned)(R * K + C) * 2u; voffB[i] = (unsigned)(Rb * K + C) * 2u; }
    const size_t kstep = (size_t)(BK * 2);
    const size_t hstep = (size_t)HALF * K * 2;
    const size_t tstep = 2 * hstep;
    const unsigned ldsw = (unsigned)wid * 1024u;
    const int aoff = lds_byte(wr * 64 + fr, fq * 8), boff = lds_byte(wc * 32 + fr, fq * 8);
#define PG8_SA(b, h) (((b) * 2 + (h)) * HTB)
#define PG8_SB(b, h) ((4 + (b) * 2 + (h)) * HTB)
#define PG8_STAGE(bufoff, gbase, voff) do { _Pragma("unroll") for (int _i = 0; _i < 2; ++_i) \
        __builtin_amdgcn_global_load_lds((const unsigned*)((const char*)(gbase) + (voff)[_i]), (PG8_LAS unsigned*)(lds + (bufoff) + ldsw + _i * 8192), 16, 0, 0); } while (0)
#define PG8_LDA(dst, b, h) do { _Pragma("unroll") for (int m = 0; m < 4; ++m) _Pragma("unroll") for (int k = 0; k < 2; ++k) dst[m][k] = *(const PG8_LAS bf16x8*)(lds + PG8_SA(b, h) + aoff + m * 2048 + k * 1024); } while (0)
#define PG8_LDB(dst, b, h) do { _Pragma("unroll") for (int n = 0; n < 2; ++n) _Pragma("unroll") for (int k = 0; k < 2; ++k) dst[n][k] = *(const PG8_LAS bf16x8*)(lds + PG8_SB(b, h) + boff + n * 2048 + k * 1024); } while (0)
#define PG8_MMA(ai, bj, At, Bt) do { __builtin_amdgcn_s_setprio(1); _Pragma("unroll") for (int m = 0; m < 4; ++m) _Pragma("unroll") for (int n = 0; n < 2; ++n) _Pragma("unroll") for (int k = 0; k < 2; ++k) \
        acc[ai][bj][m][n] = __builtin_amdgcn_mfma_f32_16x16x32_bf16(Bt[n][k], At[m][k], acc[ai][bj][m][n], 0, 0, 0); __builtin_amdgcn_s_setprio(0); } while (0)
#define PG8_WAIT_V(n) asm volatile("s_waitcnt vmcnt(" #n ")" ::: "memory")
#define PG8_WAIT_L(n) asm volatile("s_waitcnt lgkmcnt(" #n ")" ::: "memory")
#define PG8_BAR __builtin_amdgcn_s_barrier()
#define PG8_SCHED __builtin_amdgcn_sched_barrier(0)
    Unit cur, nxt; int ui = 0;
    if (!S.next(0, cur)) return;
    f32x4 acc[2][2][4][2];
#pragma unroll
    for (int a = 0; a < 2; ++a)
#pragma unroll
        for (int b = 0; b < 2; ++b)
#pragma unroll
            for (int m = 0; m < 4; ++m)
#pragma unroll
                for (int n = 0; n < 2; ++n) acc[a][b][m][n] = (f32x4){0.f, 0.f, 0.f, 0.f};
    bf16x8 At[4][2], B0[2][2], B1[2][2];
    const char* cA = (const char*)g.A + (size_t)cur.pm * tstep; const char* cB = (const char*)g.Bt + (size_t)cur.pn * tstep;
    S.a_ready(cur);
    if constexpr (SP2) {
        PG8_STAGE(PG8_SB(0, 0), cB, voffB); PG8_STAGE(PG8_SB(0, 1), cB + hstep, voffB); PG8_STAGE(PG8_SA(0, 0), cA, voffA); PG8_STAGE(PG8_SA(0, 1), cA + hstep, voffA);
        if (wr == 1) PG8_BAR;
        PG8_WAIT_V(2); PG8_BAR;
        PG8_STAGE(PG8_SB(1, 0), cB + kstep, voffB); PG8_STAGE(PG8_SA(1, 0), cA + kstep, voffA); PG8_STAGE(PG8_SB(1, 1), cB + hstep + kstep, voffB);
        PG8_WAIT_V(6); PG8_BAR;
    } else {
        PG8_STAGE(PG8_SB(0, 0), cB, voffB); PG8_STAGE(PG8_SA(0, 0), cA, voffA); PG8_STAGE(PG8_SB(0, 1), cB + hstep, voffB); PG8_STAGE(PG8_SA(0, 1), cA + hstep, voffA);
        if (wr == 1) PG8_BAR;
        PG8_WAIT_V(4); PG8_BAR;
        PG8_STAGE(PG8_SB(1, 0), cB + kstep, voffB); PG8_STAGE(PG8_SA(1, 0), cA + kstep, voffA); PG8_STAGE(PG8_SB(1, 1), cB + hstep + kstep, voffB);
        PG8_WAIT_V(6); PG8_BAR;
    }
    for (;;) {
        const bool has_next = S.next(ui + 1, nxt);
        const char* nA = has_next ? (const char*)g.A + (size_t)nxt.pm * tstep : cA; const char* nB = has_next ? (const char*)g.Bt + (size_t)nxt.pn * tstep : cB;
        for (int t = 0; t < nt; t += 2) {
            const bool last = (t == nt - 2);
            const char* a1 = cA + (size_t)(t + 1) * kstep;
            const char* a2 = last ? nA : cA + (size_t)(t + 2) * kstep; const char* b2 = last ? nB : cB + (size_t)(t + 2) * kstep;
            const char* a3 = a2 + kstep; const char* b3 = b2 + kstep;
            if (last && has_next) S.a_ready(nxt);
            if constexpr (SP2) {
            PG8_LDB(B0, 0, 0); PG8_LDB(B1, 0, 1); PG8_SCHED; PG8_LDA(At, 0, 0); PG8_STAGE(PG8_SA(1, 1), a1 + hstep, voffA);
            PG8_WAIT_V(8); PG8_WAIT_L(0); PG8_BAR; PG8_MMA(0, 0, At, B0); PG8_MMA(0, 1, At, B1); PG8_BAR; PG8_SCHED;
            PG8_LDA(At, 0, 1); PG8_STAGE(PG8_SB(0, 0), b2, voffB); PG8_STAGE(PG8_SB(0, 1), b2 + hstep, voffB); PG8_STAGE(PG8_SA(0, 0), a2, voffA);
            PG8_WAIT_V(8); PG8_WAIT_L(0); PG8_BAR; PG8_MMA(1, 0, At, B0); PG8_MMA(1, 1, At, B1); PG8_BAR; PG8_SCHED;
            PG8_LDB(B0, 1, 0); PG8_LDB(B1, 1, 1); PG8_SCHED; PG8_LDA(At, 1, 0); PG8_STAGE(PG8_SA(0, 1), a2 + hstep, voffA);
            PG8_WAIT_V(8); PG8_WAIT_L(0); PG8_BAR; PG8_MMA(0, 0, At, B0); PG8_MMA(0, 1, At, B1); PG8_BAR; PG8_SCHED;
            PG8_LDA(At, 1, 1); PG8_STAGE(PG8_SB(1, 0), b3, voffB); PG8_STAGE(PG8_SB(1, 1), b3 + hstep, voffB); PG8_STAGE(PG8_SA(1, 0), a3, voffA);
            PG8_WAIT_V(8); PG8_WAIT_L(0); PG8_BAR; PG8_MMA(1, 0, At, B0); PG8_MMA(1, 1, At, B1); PG8_BAR; PG8_SCHED;
            } else {
            PG8_LDB(B0, 0, 0); PG8_SCHED; PG8_LDA(At, 0, 0); PG8_STAGE(PG8_SA(1, 1), a1 + hstep, voffA);
            PG8_WAIT_L(8); PG8_BAR; PG8_WAIT_L(0); PG8_MMA(0, 0, At, B0); PG8_BAR; PG8_SCHED;
            PG8_LDB(B1, 0, 1); PG8_STAGE(PG8_SB(0, 0), b2, voffB);
            PG8_BAR; PG8_WAIT_L(0); PG8_MMA(0, 1, At, B1); PG8_BAR;
            PG8_LDA(At, 0, 1); PG8_STAGE(PG8_SA(0, 0), a2, voffA);
            PG8_BAR; PG8_WAIT_L(0); PG8_MMA(1, 0, At, B0); PG8_BAR; PG8_SCHED;
            PG8_STAGE(PG8_SB(0, 1), b2 + hstep, voffB);
            PG8_WAIT_V(6); PG8_BAR; PG8_MMA(1, 1, At, B1); PG8_BAR;
            PG8_LDB(B0, 1, 0); PG8_SCHED; PG8_LDA(At, 1, 0); PG8_STAGE(PG8_SA(0, 1), a2 + hstep, voffA);
            PG8_WAIT_L(8); PG8_BAR; PG8_WAIT_L(0); PG8_MMA(0, 0, At, B0); PG8_BAR; PG8_SCHED;
            PG8_LDB(B1, 1, 1); PG8_STAGE(PG8_SB(1, 0), b3, voffB);
            PG8_BAR; PG8_WAIT_L(0); PG8_MMA(0, 1, At, B1); PG8_BAR;
            PG8_LDA(At, 1, 1); PG8_STAGE(PG8_SA(1, 0), a3, voffA);
            PG8_BAR; PG8_WAIT_L(0); PG8_MMA(1, 0, At, B0); PG8_BAR; PG8_SCHED;
            PG8_STAGE(PG8_SB(1, 1), b3 + hstep, voffB);
            PG8_WAIT_V(6); PG8_BAR; PG8_MMA(1, 1, At, B1); PG8_BAR;
            }
        }
        if constexpr (ALIGN_EPI) { if (wr == 0) PG8_BAR; }
        if constexpr (!Epi::AFTER_DRAIN) { E(acc, cur, wr, wc, fr, fq); S.done(cur); }
        if (!has_next) break;
#pragma unroll
        for (int a = 0; a < 2; ++a)
#pragma unroll
            for (int b = 0; b < 2; ++b)
#pragma unroll
                for (int m = 0; m < 4; ++m)
#pragma unroll
                    for (int n = 0; n < 2; ++n) acc[a][b][m][n] = (f32x4){0.f, 0.f, 0.f, 0.f};
        cur = nxt; cA = nA; cB = nB; ++ui;
        if constexpr (ALIGN_EPI) { if (wr == 1) PG8_BAR; }
    }
    PG8_WAIT_V(0);
    if constexpr (!ALIGN_EPI) { if (wr == 0) PG8_BAR; }
    PG8_BAR;
#undef PG8_SA
#undef PG8_SB
#undef PG8_STAGE
#undef PG8_LDA
#undef PG8_LDB
#undef PG8_MMA
#undef PG8_WAIT_V
#undef PG8_WAIT_L
#undef PG8_BAR
#undef PG8_SCHED
}
}

#ifndef PG8_SP2
#define PG8_SP2 true
#endif
#ifndef PG8_ALIGN
#define PG8_ALIGN true
#endif

constexpr int NWAVES = 8;
constexpr int N_LAUNCHES = MK_N_LAUNCHES;
constexpr int PER_PHASE = 10;

constexpr size_t MiB = 1u << 20;
constexpr size_t WS_CTL = 0, CTL_ZERO_BYTES = 2 * MiB;
constexpr size_t WS_SSQ = 1 * MiB;
constexpr size_t WS_MOD = 2 * MiB;
constexpr size_t WS_BIAS = 2 * MiB + 512 * 1024;
constexpr size_t WS_ROPE = 3 * MiB;
constexpr size_t WS_PART = 4 * MiB;
constexpr size_t WS_WIN = 8 * MiB;
constexpr size_t WS_WUQ = 16 * MiB;
constexpr size_t WS_WUKV = 18 * MiB;
constexpr size_t WS_WOUT = 20 * MiB;
constexpr size_t WS_W1 = 28 * MiB;
constexpr size_t WS_W2 = 60 * MiB;
constexpr size_t WS_H = 92 * MiB;
constexpr size_t WS_QA = 92 * MiB;
constexpr size_t WS_KA = 124 * MiB;
constexpr size_t WS_VA = 128 * MiB;
constexpr size_t WS_CQ = 132 * MiB;
constexpr size_t WS_CKV = 144 * MiB;
constexpr size_t WS_KR = 148 * MiB;
constexpr size_t WS_QB = 150 * MiB;
constexpr size_t WS_KN = 198 * MiB;
constexpr size_t WS_VB = 230 * MiB;
constexpr size_t WS_MIX = 262 * MiB;
constexpr size_t WS_XN = 348 * MiB;
constexpr size_t WS_END = 412 * MiB;
static_assert(WS_MIX + (size_t)M * DM * 2 <= WS_H + (size_t)M * FF * 2 && WS_H + (size_t)M * FF * 2 <= WS_XN && WS_XN + (size_t)M * DM * 2 <= WS_END, "d_ws map");
constexpr int CW_TMO = 0, CW_CODE = 1;
constexpr int CW_BAR = 4096;

constexpr int RING_OFF = 0, RING_BYTES = 131072;
constexpr int LDSCTL_OFF = RING_BYTES, MISC_OFF = LDSCTL_OFF + 320;
constexpr int LDS_EXTRA_OFF = 132 * 1024;
constexpr int LDS_BYTES = 147456;

#define GAS __attribute__((address_space(1)))
#define LAS __attribute__((address_space(3)))
typedef unsigned short bf16;
typedef unsigned v4u __attribute__((ext_vector_type(4)));
typedef unsigned v2u __attribute__((ext_vector_type(2)));
typedef float f32x4 __attribute__((ext_vector_type(4)));
typedef float f32x2 __attribute__((ext_vector_type(2)));
typedef short bf16x8 __attribute__((ext_vector_type(8)));
typedef GAS unsigned gu32;
#define RLX_AGENT __ATOMIC_RELAXED, __HIP_MEMORY_SCOPE_AGENT
#define LDS_WAIT() asm volatile("s_waitcnt lgkmcnt(0)" ::: "memory")
#define VM_WAIT() asm volatile("s_waitcnt vmcnt(0)" ::: "memory")
__device__ __forceinline__ unsigned f2bf(float f) { unsigned u = __builtin_bit_cast(unsigned, f); return (u + 0x7fffu + ((u >> 16) & 1u)) >> 16; }
__device__ __forceinline__ unsigned pk2(float lo, float hi) { return f2bf(lo) | (f2bf(hi) << 16); }
__device__ __forceinline__ float bf2f(unsigned h) { return __builtin_bit_cast(float, h << 16); }

#define XB_TMO      128
#define XB_XCNT(j)  (256  + 64 * (j))
#define XB_XSUB(j)  (1280 + 64 * (j))
#define XB_XGEN(j)  (2304 + 64 * (j))
#define XB_TOP      3328
#define XB_TOPGEN   3392
#define XCD_BAR_WORDS 3456
#define XB_SPIN_CAP (1u << 18)
__device__ __forceinline__ unsigned xb_ld(unsigned* p)              { return __hip_atomic_load(p, __ATOMIC_RELAXED, __HIP_MEMORY_SCOPE_AGENT); }
__device__ __forceinline__ unsigned xb_add(unsigned* p, unsigned v) { return __hip_atomic_fetch_add(p, v, __ATOMIC_RELAXED, __HIP_MEMORY_SCOPE_AGENT); }
__device__ __forceinline__ unsigned xb_xcc_id() { return (unsigned)__builtin_amdgcn_s_getreg((3 << 11) | 20) & 0xFu; }
#define XB_SPIN(cond, bar) do { unsigned _sp = 0; while (cond) { __builtin_amdgcn_s_sleep(1); \
    if ((++_sp & 255u) == 0u) { if (xb_ld(&(bar)[XB_TMO])) break; if (_sp > XB_SPIN_CAP) { atomicAdd(&(bar)[XB_TMO], 1u); break; } } } } while (0)
struct XcdBarrier { unsigned* bar; unsigned x; volatile LAS unsigned* st; };
__device__ __forceinline__ XcdBarrier xcd_barrier_post(unsigned* bar, volatile LAS unsigned* st) {
    XcdBarrier b; b.bar = bar; b.x = xb_xcc_id(); b.st = st;
    if (threadIdx.x == 0) (void)xb_add(&bar[XB_XCNT(b.x)], 1u);
    return b;
}
__device__ __forceinline__ void xcd_barrier_complete(unsigned* bar, unsigned x, unsigned& nloc, unsigned& nx) {
    const unsigned G = gridDim.x * gridDim.y * gridDim.z;
    unsigned sum, cnt, mine, sp = 0u;
    for (;;) {
        sum = 0u; cnt = 0u; mine = 0u;
#pragma unroll
        for (unsigned j = 0; j < 16; ++j) { const unsigned c = xb_ld(&bar[XB_XCNT(j)]); sum += c; cnt += (c > 0u) ? 1u : 0u; mine = (j == x) ? c : mine; }
        if (sum == G) break;
        __builtin_amdgcn_s_sleep(1);
        if ((++sp & 255u) == 0u) { if (xb_ld(&bar[XB_TMO])) break; if (sp > XB_SPIN_CAP) { atomicAdd(&bar[XB_TMO], 1u); break; } }
    }
    nloc = mine > 0u ? mine : 1u; nx = cnt > 0u ? cnt : 1u;
}
__device__ __forceinline__ void xcd_barrier(const XcdBarrier& b) {
    asm volatile("s_waitcnt vmcnt(0)" ::: "memory");
    __syncthreads();
    if (threadIdx.x == 0) {
        unsigned* bar = b.bar;
        __builtin_amdgcn_s_waitcnt(0);
        unsigned nloc = b.st[0], nx = b.st[1];
        if (nloc == 0u) { xcd_barrier_complete(bar, b.x, nloc, nx); b.st[0] = nloc; b.st[1] = nx; }
        const unsigned old = xb_add(&bar[XB_XSUB(b.x)], 1u);
        const unsigned gen = old / nloc;
        if (old + 1u == (gen + 1u) * nloc) {
            __builtin_amdgcn_fence(__ATOMIC_RELEASE, "agent");
            asm volatile("s_waitcnt vmcnt(0)" ::: "memory");
            const unsigned og = xb_add(&bar[XB_TOP], 1u);
            const unsigned tg = og / nx;
            if (og + 1u == (tg + 1u) * nx) xb_add(&bar[XB_TOPGEN], 1u);
            else XB_SPIN(xb_ld(&bar[XB_TOPGEN]) == tg, bar);
            __builtin_amdgcn_fence(__ATOMIC_ACQUIRE, "agent");
            xb_add(&bar[XB_XGEN(b.x)], 1u);
            asm volatile("s_waitcnt vmcnt(0)" ::: "memory");
        } else {
            XB_SPIN(xb_ld(&bar[XB_XGEN(b.x)]) == gen, bar);
            __builtin_amdgcn_fence(__ATOMIC_ACQUIRE, "agent");
            asm volatile("s_waitcnt vmcnt(0)" ::: "memory");
        }
    }
    __syncthreads();
}

struct Frame {
    LAS unsigned char* lds;
    volatile LAS unsigned* MISC;
    gu32* ctl;
    int tid, lane, wave;
    int vcu, G;
    unsigned char* ws; float* out;
};
constexpr int INPTR_OFF = LDSCTL_OFF + 512;
__device__ __forceinline__ const float* in_ptr(const Frame& F, int k) {
    const unsigned long long v = ((const LAS unsigned long long*)(F.lds + INPTR_OFF))[k];
    const unsigned lo = __builtin_amdgcn_readfirstlane((unsigned)v), hi = __builtin_amdgcn_readfirstlane((unsigned)(v >> 32));
    return (const float*)(((unsigned long long)hi << 32) | lo);
}
#define WSP(T, off) ((T*)(F.ws + (off)))


__device__ __forceinline__ float wave_sum(float v) {
#pragma unroll
    for (int o = 1; o < 64; o <<= 1) v += __shfl_xor(v, o);
    return v;
}
__device__ __forceinline__ float wave_max(float v) {
#pragma unroll
    for (int o = 1; o < 64; o <<= 1) v = fmaxf(v, __shfl_xor(v, o));
    return v;
}

__device__ __forceinline__ int t5_bucket(int n) {
    if (n < 16) return n;
    const unsigned char T[112] = {16,16,16,17,17,18,18,18,19,19,19,20,20,20,20,21,21,21,21,22,22,22,22,22,23,23,23,23,23,23,24,24,24,24,24,24,25,25,25,25,25,25,25,26,26,26,26,26,26,26,26,27,27,27,27,27,27,27,27,27,27,28,28,28,28,28,28,28,28,28,28,29,29,29,29,29,29,29,29,29,29,29,29,30,30,30,30,30,30,30,30,30,30,30,30,30,30,31,31,31,31,31,31,31,31,31,31,31,31,31,31,31};
    return T[n - 16];
}

__device__ __forceinline__ void sincos_acc(float ang, float& s_out, float& c_out) {
    const double x = (double)ang;
    const double k = __builtin_rint(x * 0.15915494309189535);
    double r = __builtin_fma(-k, 6.283185307179586, x); r = __builtin_fma(-k, 2.4492935982947064e-16, r);
    const double y = r * 0.25, y2 = y * y;
    double s = y * (1.0 + y2 * (-1.0 / 6 + y2 * (1.0 / 120 + y2 * (-1.0 / 5040 + y2 * (1.0 / 362880 + y2 * (-1.0 / 39916800 + y2 * (1.0 / 6227020800.0)))))));
    double c = 1.0 + y2 * (-0.5 + y2 * (1.0 / 24 + y2 * (-1.0 / 720 + y2 * (1.0 / 40320 + y2 * (-1.0 / 3628800 + y2 * (1.0 / 479001600.0))))));
    double s2 = 2.0 * s * c, c2 = 1.0 - 2.0 * s * s;
    double s4 = 2.0 * s2 * c2, c4 = 1.0 - 2.0 * s2 * s2;
    s_out = (float)s4; c_out = (float)c4;
}

template <int MODE> __device__ __forceinline__ int dst_row(int n) {
    if (MODE == 1) { if (n >= OFF_KR) { const int j = n - OFF_KR; return OFF_KR + 2 * (j & 31) + (j >> 5); } return n; }
    if (MODE == 2) { const int h = n / 192, w = n - h * 192; if (w >= 128) { const int j = w - 128; return h * 192 + 128 + 2 * (j & 31) + (j >> 5); } return n; }
    return n;
}
struct TrItem { const float* W; bf16* WT; const float* gs; int K, N, mode, k0, n0; };
constexpr int I_IN = (DM / 64) * (IN_COLS / 32), I_UQ = (QRANK / 64) * (NQB / 32), I_UKV = (KVRANK / 64) * (NKVB / 32), I_OUT = (DM / 64) * (DM / 32), I_1 = (DM / 64) * (FF / 32), I_2 = (FF / 64) * (DM / 32);
constexpr int N_ITEMS = I_IN + I_UQ + I_UKV + I_OUT + I_1 + I_2;
__device__ __forceinline__ TrItem tr_item(const Frame& F, int r) {
    TrItem t;
    if (r < I_IN) { t.W = in_ptr(F, 5); t.WT = WSP(bf16, WS_WIN); t.gs = nullptr; t.K = DM; t.N = IN_COLS; t.mode = 1; }
    else if ((r -= I_IN) < I_UQ) { t.W = in_ptr(F, 9); t.WT = WSP(bf16, WS_WUQ); t.gs = in_ptr(F, 8); t.K = QRANK; t.N = NQB; t.mode = 2; }
    else if ((r -= I_UQ) < I_UKV) { t.W = in_ptr(F, 11); t.WT = WSP(bf16, WS_WUKV); t.gs = in_ptr(F, 10); t.K = KVRANK; t.N = NKVB; t.mode = 0; }
    else if ((r -= I_UKV) < I_OUT) { t.W = in_ptr(F, 12); t.WT = WSP(bf16, WS_WOUT); t.gs = nullptr; t.K = DM; t.N = DM; t.mode = 0; }
    else if ((r -= I_OUT) < I_1) { t.W = in_ptr(F, 14); t.WT = WSP(bf16, WS_W1); t.gs = nullptr; t.K = DM; t.N = FF; t.mode = 0; }
    else { r -= I_1; t.W = in_ptr(F, 15); t.WT = WSP(bf16, WS_W2); t.gs = nullptr; t.K = FF; t.N = DM; t.mode = 0; }
    const int nblk = t.N / 32, kb = r / nblk, nb = r - kb * nblk; t.k0 = 64 * kb; t.n0 = 32 * nb;
    return t;
}
__device__ __forceinline__ void tr_load(const TrItem& t, int lane, f32x4 (&v)[8]) {
    const float* p = t.W + (size_t)(t.k0 + (lane >> 3)) * t.N + t.n0 + 4 * (lane & 7);
#pragma unroll
    for (int i = 0; i < 8; ++i) v[i] = *(const GAS f32x4*)(p + (size_t)(8 * i) * t.N);
}
__device__ __forceinline__ void tr_store(const TrItem& t, int lane, const f32x4 (&v)[8], LAS float* scr) {
    { LAS float* w = scr + (lane >> 3) * 33 + 4 * (lane & 7);
#pragma unroll
      for (int i = 0; i < 8; ++i) { w[i * 264 + 0] = v[i][0]; w[i * 264 + 1] = v[i][1]; w[i * 264 + 2] = v[i][2]; w[i * 264 + 3] = v[i][3]; } }
    LDS_WAIT(); asm volatile("" ::: "memory");
    const int c = lane & 7;
    float g[8];
#pragma unroll
    for (int e = 0; e < 8; ++e) g[e] = t.gs ? t.gs[t.k0 + 8 * c + e] : 1.0f;
#pragma unroll
    for (int j = 0; j < 4; ++j) { const int n = (lane >> 3) + 8 * j; const LAS float* s = scr + (8 * c) * 33 + n;
        v4u o; o.x = pk2(s[0 * 33] * g[0], s[1 * 33] * g[1]); o.y = pk2(s[2 * 33] * g[2], s[3 * 33] * g[3]); o.z = pk2(s[4 * 33] * g[4], s[5 * 33] * g[5]); o.w = pk2(s[6 * 33] * g[6], s[7 * 33] * g[7]);
        const int nn = t.n0 + n, dr = t.mode == 1 ? dst_row<1>(nn) : t.mode == 2 ? dst_row<2>(nn) : nn;
        *(GAS v4u*)(t.WT + (size_t)dr * t.K + t.k0 + 8 * c) = o; }
    LDS_WAIT(); asm volatile("" ::: "memory");
}
constexpr int MOD_KS = 16, MOD_N = 6 * DM, MOD_CG = MOD_N / 256;
__device__ __forceinline__ void p0_prologue(Frame& F) {
    LAS float* sil = (LAS float*)(F.lds + RING_OFF);
    LAS float* scr = (LAS float*)(F.lds + RING_OFF + 32768 + F.wave * 8704);
    for (int i = F.tid; i < NB * DM; i += NWAVES * 64) { const float v = in_ptr(F, 1)[i]; sil[i] = v / (1.0f + __expf(-v)); }
    __syncthreads();
    const int gw = F.vcu * NWAVES + F.wave, NGW = F.G * NWAVES, lane = F.lane;
    constexpr int T_MOD = MOD_KS * MOD_CG;
    if (gw < T_MOD) {
        const int cg = gw % MOD_CG, ks = gw / MOD_CG, j0 = cg * 256 + 4 * lane, k0 = ks * (DM / MOD_KS);
        const float* wp = in_ptr(F, 2) + (size_t)k0 * MOD_N + j0;
        f32x4 acc[4] = {{0.f, 0.f, 0.f, 0.f}, {0.f, 0.f, 0.f, 0.f}, {0.f, 0.f, 0.f, 0.f}, {0.f, 0.f, 0.f, 0.f}};
        for (int kk = 0; kk < DM / MOD_KS; kk += 16) {
            f32x4 w[16];
#pragma unroll
            for (int u = 0; u < 16; ++u) w[u] = *(const GAS f32x4*)(wp + (size_t)(kk + u) * MOD_N);
#pragma unroll
            for (int u = 0; u < 16; ++u)
#pragma unroll
                for (int b = 0; b < 4; ++b) acc[b] += sil[b * DM + k0 + kk + u] * w[u];
        }
#pragma unroll
        for (int b = 0; b < 4; ++b) *(GAS f32x4*)(WSP(float, WS_PART) + (size_t)(ks * 4 + b) * MOD_N + j0) = acc[b];
    }
    {
        const int nsl = gw < T_MOD ? 1 : 4, base = gw < T_MOD ? gw : T_MOD + (gw - T_MOD) * 4, SLOTS = T_MOD + (NGW - T_MOD) * 4;
        f32x4 va[8], vb[8];
        int q = 0; int it = base;
        if (it < N_ITEMS) { TrItem ta = tr_item(F, it); tr_load(ta, lane, va);
            for (;;) {
                ++q; const int itn = (q / nsl) * SLOTS + base + (q % nsl); const bool more = itn < N_ITEMS;
                TrItem tb = tr_item(F, more ? itn : it);
                if (more) tr_load(tb, lane, vb);
                tr_store(ta, lane, va, scr);
                if (!more) break;
#pragma unroll
                for (int i = 0; i < 8; ++i) va[i] = vb[i];
                ta = tb; it = itn;
            } }
    }
    constexpr int T_PAD = IN_PAD - IN_COLS, T_ROPE = SEQ * 32 / 64, T_BIAS = 16 * 128 / 64;
    for (int it = gw; it < T_PAD + T_ROPE + T_BIAS; it += NGW) {
        int r = it;
        if (r < T_PAD) {
            GAS v4u* o = (GAS v4u*)(WSP(bf16, WS_WIN) + (size_t)(IN_COLS + r) * DM) + lane;
#pragma unroll
            for (int j = 0; j < 4; ++j) o[64 * j] = (v4u){0u, 0u, 0u, 0u};
            continue;
        }
        r -= T_PAD;
        if (r < T_ROPE) {
            const int pos = 2 * r + (lane >> 5), i = lane & 31;
            double f = 1.0; for (int e = 0; e < i; ++e) f *= 0.7498942093324559;
            const float ang = (float)pos * (float)f;
            float s, c; sincos_acc(ang, s, c);
            *(GAS f32x2*)(WSP(float, WS_ROPE) + ((size_t)pos * 32 + i) * 2) = (f32x2){c, s};
            continue;
        }
        r -= T_ROPE;
        { const int e = r * 64 + lane, head = e >> 7, dist = e & 127;
          WSP(float, WS_BIAS)[e] = in_ptr(F, 7)[t5_bucket(dist) * 16 + head] * LOG2E; }
    }
}

template <bool FROM_PART> __device__ __forceinline__ void norm_mod_phase(Frame& F, const float* xin, const float* gvec, int sh_chunk, int sc_chunk) {
    LAS f32x2* ab = (LAS f32x2*)(F.lds + RING_OFF);
    const int b = F.vcu / (SEQ / 64);
    for (int k = F.tid; k < DM; k += NWAVES * 64) {
        float sc, sh;
        if (FROM_PART) { float a[MOD_KS], c[MOD_KS];
#pragma unroll
            for (int ks = 0; ks < MOD_KS; ++ks) { const float* p = WSP(float, WS_PART) + (size_t)(ks * 4 + b) * MOD_N; a[ks] = p[sc_chunk * DM + k]; c[ks] = p[sh_chunk * DM + k]; }
            sc = in_ptr(F, 3)[sc_chunk * DM + k]; sh = in_ptr(F, 3)[sh_chunk * DM + k];
#pragma unroll
            for (int ks = 0; ks < MOD_KS; ++ks) { sc += a[ks]; sh += c[ks]; } }
        else { sc = WSP(float, WS_MOD)[b * MOD_N + sc_chunk * DM + k]; sh = WSP(float, WS_MOD)[b * MOD_N + sh_chunk * DM + k]; }
        ab[k] = (f32x2){gvec[k] * (1.0f + sc), sh};
    }
    if (FROM_PART) {
        const int o = F.vcu * (NB * MOD_N / 256) + F.tid;
        if (F.tid < NB * MOD_N / 256) { const int bb = o / MOD_N, j = o - bb * MOD_N; float a[MOD_KS];
#pragma unroll
            for (int ks = 0; ks < MOD_KS; ++ks) a[ks] = WSP(float, WS_PART)[(size_t)(ks * 4 + bb) * MOD_N + j];
            float s_ = in_ptr(F, 3)[j];
#pragma unroll
            for (int ks = 0; ks < MOD_KS; ++ks) s_ += a[ks];
            WSP(float, WS_MOD)[o] = s_; }
    }
    __syncthreads();
    for (int i = 0; i < 8; i += 2) {
        const int row = F.vcu * 64 + F.wave * 8 + i;
        const GAS f32x4* xr = (const GAS f32x4*)(xin + (size_t)row * DM) + F.lane;
        f32x4 v[2][8]; float s[2] = {0.f, 0.f};
#pragma unroll
        for (int u = 0; u < 2; ++u)
#pragma unroll
            for (int j = 0; j < 8; ++j) v[u][j] = xr[u * (DM / 4) + 64 * j];
#pragma unroll
        for (int u = 0; u < 2; ++u) {
#pragma unroll
            for (int j = 0; j < 8; ++j) s[u] += (v[u][j].x * v[u][j].x + v[u][j].y * v[u][j].y) + (v[u][j].z * v[u][j].z + v[u][j].w * v[u][j].w);
            const float rstd = 1.0f / sqrtf(wave_sum(s[u]) * (1.0f / DM) + EPS);
            GAS v2u* o8 = (GAS v2u*)(WSP(bf16, WS_XN) + (size_t)(row + u) * DM) + F.lane;
#pragma unroll
            for (int j = 0; j < 8; ++j) { const int k = 4 * (F.lane + 64 * j);
                const f32x2 a0 = ab[k], a1 = ab[k + 1], a2 = ab[k + 2], a3 = ab[k + 3];
                o8[64 * j] = (v2u){pk2(v[u][j].x * rstd * a0.x + a0.y, v[u][j].y * rstd * a1.x + a1.y), pk2(v[u][j].z * rstd * a2.x + a2.y, v[u][j].w * rstd * a3.x + a3.y)}; }
        }
    }
}
__device__ __forceinline__ void final_norm_phase(Frame& F) {
    const int gw = F.vcu * NWAVES + F.wave, NGW = F.G * NWAVES;
    f32x4 g[8];
#pragma unroll
    for (int j = 0; j < 8; ++j) g[j] = *((const GAS f32x4*)in_ptr(F, 16) + F.lane + 64 * j);
    for (int row = gw; row < M; row += 2 * NGW) {
        f32x4 v[2][8];
#pragma unroll
        for (int u = 0; u < 2; ++u) { const GAS f32x4* xr = (const GAS f32x4*)(F.out + (size_t)(row + u * NGW) * DM) + F.lane;
#pragma unroll
            for (int j = 0; j < 8; ++j) v[u][j] = xr[64 * j]; }
#pragma unroll
        for (int u = 0; u < 2; ++u) { float s = 0.f;
#pragma unroll
            for (int j = 0; j < 8; ++j) s += (v[u][j].x * v[u][j].x + v[u][j].y * v[u][j].y) + (v[u][j].z * v[u][j].z + v[u][j].w * v[u][j].w);
            const float rstd = 1.0f / sqrtf(wave_sum(s) * (1.0f / DM) + EPS);
            GAS f32x4* xo = (GAS f32x4*)(F.out + (size_t)(row + u * NGW) * DM) + F.lane;
#pragma unroll
            for (int j = 0; j < 8; ++j) xo[64 * j] = v[u][j] * rstd * g[j]; }
    }
}
__device__ __forceinline__ void nan_rows_f32(Frame& F, float* out) {
    const int gw = F.vcu * NWAVES + F.wave, NGW = F.G * NWAVES; const float q = __builtin_nanf("");
    for (int m = gw; m < M; m += NGW) { GAS f32x4* o = (GAS f32x4*)(out + (size_t)m * DM) + F.lane;
#pragma unroll
        for (int j = 0; j < 8; ++j) o[64 * j] = (f32x4){q, q, q, q}; }
}

struct NoCtx {};
__device__ __forceinline__ void st_bf4(bf16* base, unsigned off, f32x4 v) { *(GAS v2u*)(base + off) = (v2u){pk2(v[0], v[1]), pk2(v[2], v[3])}; }
__device__ __forceinline__ f32x4 rope4(const float* ROPE, unsigned pos, unsigned p, f32x4 v) {
    const f32x4 cs = *(const GAS f32x4*)(ROPE + (pos * 64u + p));
    return (f32x4){v[0] * cs[0] - v[1] * cs[1], v[1] * cs[0] + v[0] * cs[1], v[2] * cs[2] - v[3] * cs[3], v[3] * cs[2] + v[2] * cs[3]};
}
template <bool ATOMIC> struct EpiIn {
    static constexpr bool HAS_SLOTS = true;
    bf16 *QA, *KA, *VA, *CQ, *CKV, *KR; float* SSQ; const float* ROPE;
    __device__ __forceinline__ bool tile_has_slots(int col0) const { return !ATOMIC && col0 >= OFF_CQ && col0 < OFF_KR; }
    __device__ __forceinline__ NoCtx row_ctx(int) const { return NoCtx{}; }
    __device__ __forceinline__ void slot_store(int row, int col32, float s) const { if (col32 >= OFF_CQ && col32 < OFF_KR) SSQ[(unsigned)row * 16u + (unsigned)((col32 - OFF_CQ) >> 5)] = s; }
    __device__ __forceinline__ void operator()(NoCtx, int row, int col, f32x4 v) const {
        const int reg = __builtin_amdgcn_readfirstlane(col >> 7);
        const unsigned r = (unsigned)row, c = (unsigned)col;
        if (reg < 8) { st_bf4(QA, r * 1024u + c, v * CA); }
        else if (reg == 8) { st_bf4(KA, r * 128u + (c - OFF_KA), v); }
        else if (reg == 9) { st_bf4(VA, r * 128u + (c - OFF_VA), v); }
        else if (reg < 14) {
            if (reg < 13) st_bf4(CQ, r * QRANK + (c - OFF_CQ), v); else st_bf4(CKV, r * KVRANK + (c - OFF_CKV), v);
            if (ATOMIC) atomicAdd(SSQ + (r * 16u + ((c - OFF_CQ) >> 5)), (v[0] * v[0] + v[1] * v[1]) + (v[2] * v[2] + v[3] * v[3]));
        }
        else if (reg == 14) { if (col < IN_COLS) st_bf4(KR, r * 64u + (c - OFF_KR), rope4(ROPE, r & (SEQ - 1), c - OFF_KR, v)); }
    }
};
struct EpiUp {
    static constexpr bool HAS_SLOTS = false;
    bf16 *QB, *KN, *VB; const float* SSQ; const float* ROPE; int mode;
    __device__ __forceinline__ bool tile_has_slots(int) const { return false; }
    __device__ __forceinline__ void slot_store(int, int, float) const {}
    __device__ __forceinline__ float row_ctx(int row) const {
        const GAS f32x4* s = (const GAS f32x4*)(SSQ + (unsigned)row * 16u);
        if (mode == 0) { const f32x4 a = s[0], b = s[1], c = s[2];
            const float t = ((a[0] + a[1]) + (a[2] + a[3])) + ((b[0] + b[1]) + (b[2] + b[3])) + ((c[0] + c[1]) + (c[2] + c[3]));
            return C2M * __builtin_amdgcn_rsqf(t * (1.0f / QRANK) + EPS); }
        const f32x4 a = s[3];
        return __builtin_amdgcn_rsqf(((a[0] + a[1]) + (a[2] + a[3])) * (1.0f / KVRANK) + EPS);
    }
    __device__ __forceinline__ void operator()(float rs, int row, int col, f32x4 v) const {
        if (mode == 0) {
            const int c32 = __builtin_amdgcn_readfirstlane(col >> 5), h = c32 / 6, w32 = c32 - 6 * h;
            if (w32 >= 4) v = rope4(ROPE, (unsigned)row & (SEQ - 1), (unsigned)(col - h * 192 - 128), v);
            st_bf4(QB, (unsigned)row * NQB + (unsigned)col, v * rs);
        } else {
            const int c128 = __builtin_amdgcn_readfirstlane(col >> 7), h = c128 >> 1;
            const unsigned off = (unsigned)row * 1024u + (unsigned)(h * 128 + (col & 127));
            if ((c128 & 1) == 0) st_bf4(KN, off, v * rs); else st_bf4(VB, off, v * rs);
        }
    }
};
struct EpiRes {
    static constexpr bool HAS_SLOTS = false;
    const float* base; float* out; const float* gate;
    __device__ __forceinline__ bool tile_has_slots(int) const { return false; }
    __device__ __forceinline__ void slot_store(int, int, float) const {}
    __device__ __forceinline__ int row_ctx(int row) const { return __builtin_amdgcn_readfirstlane(row / SEQ); }
    __device__ __forceinline__ void operator()(int b, int row, int col, f32x4 v) const {
        const unsigned off = (unsigned)row * DM + (unsigned)col;
        const f32x4 g = *(const GAS f32x4*)(gate + b * MOD_N + col), x0 = *(const GAS f32x4*)(base + off);
        *(GAS f32x4*)(out + off) = x0 + g * v;
    }
};
struct EpiRelu2 {
    static constexpr bool HAS_SLOTS = false;
    bf16* H;
    __device__ __forceinline__ bool tile_has_slots(int) const { return false; }
    __device__ __forceinline__ void slot_store(int, int, float) const {}
    __device__ __forceinline__ NoCtx row_ctx(int) const { return NoCtx{}; }
    __device__ __forceinline__ void operator()(NoCtx, int row, int col, f32x4 v) const {
        f32x4 u;
#pragma unroll
        for (int e = 0; e < 4; ++e) { const float t = fmaxf(v[e], 0.f); u[e] = t * t; }
        st_bf4(H, (unsigned)row * FF + (unsigned)col, u);
    }
};

template <class Fn> __device__ __forceinline__ void naive_gemm(Frame& F, const bf16* A, const bf16* Bt, int Mr, int N, int K, const Fn& f) {
    const int gw = F.vcu * NWAVES + F.wave, NGW = F.G * NWAVES, fr = F.lane & 15, fq = F.lane >> 4;
    const int tn = N / 32, ntiles = (Mr / 32) * tn;
    for (int t = gw; t < ntiles; t += NGW) {
        const int row0 = (t / tn) * 32, col0 = (t % tn) * 32;
        f32x4 acc[2][2];
#pragma unroll
        for (int a = 0; a < 2; ++a)
#pragma unroll
            for (int b = 0; b < 2; ++b) acc[a][b] = (f32x4){0.f, 0.f, 0.f, 0.f};
        for (int k = 0; k < K; k += 32) {
            bf16x8 a[2], b[2];
#pragma unroll
            for (int i = 0; i < 2; ++i) { a[i] = *(const GAS bf16x8*)(A + (size_t)(row0 + 16 * i + fr) * K + k + 8 * fq); b[i] = *(const GAS bf16x8*)(Bt + (size_t)(col0 + 16 * i + fr) * K + k + 8 * fq); }
#pragma unroll
            for (int mi = 0; mi < 2; ++mi)
#pragma unroll
                for (int ni = 0; ni < 2; ++ni) acc[mi][ni] = __builtin_amdgcn_mfma_f32_16x16x32_bf16(b[ni], a[mi], acc[mi][ni], 0, 0, 0);
        }
#pragma unroll
        for (int mi = 0; mi < 2; ++mi) { const int row = row0 + 16 * mi + fr; const auto rc = f.row_ctx(row);
#pragma unroll
            for (int ni = 0; ni < 2; ++ni) f(rc, row, col0 + 16 * ni + 4 * fq, acc[mi][ni]); }
    }
}

__device__ __forceinline__ void naive_swa(Frame& F) {
    const int gw = F.vcu * NWAVES + F.wave, NGW = F.G * NWAVES, lane = F.lane;
    for (int t = gw; t < NB * 16 * SEQ; t += NGW) {
        const int pos = t % SEQ, head = (t / SEQ) % 16, b = t / (SEQ * 16), hk = head >> 3;
        const size_t row = (size_t)b * SEQ + pos;
        const bf16* q = WSP(bf16, WS_QA) + row * 1024 + head * 64;
        float sc[2];
#pragma unroll
        for (int u = 0; u < 2; ++u) {
            const int kp = pos - 127 + lane + 64 * u; float s = -INFINITY;
            if (kp >= 0) { const bf16* kr = WSP(bf16, WS_KA) + ((size_t)b * SEQ + kp) * 128 + hk * 64; float a = 0.f;
                for (int d = 0; d < 64; d += 8) { const bf16x8 kv = *(const GAS bf16x8*)(kr + d), qv = *(const GAS bf16x8*)(q + d);
#pragma unroll
                    for (int e = 0; e < 8; ++e) a += bf2f((unsigned short)kv[e]) * bf2f((unsigned short)qv[e]); }
                s = a + WSP(float, WS_BIAS)[head * 128 + (pos - kp)]; }
            sc[u] = s;
        }
        const float sink = in_ptr(F, 6)[head] * LOG2E;
        const float m = fmaxf(wave_max(fmaxf(sc[0], sc[1])), sink);
        const float p0 = __builtin_amdgcn_exp2f(sc[0] - m), p1 = __builtin_amdgcn_exp2f(sc[1] - m);
        const float l = wave_sum(p0 + p1) + __builtin_amdgcn_exp2f(sink - m);
        float o = 0.f;
        for (int kk = 0; kk < 128; ++kk) { const float pk = __shfl(kk < 64 ? p0 : p1, kk & 63); const int kp = pos - 127 + kk;
            if (kp >= 0) o += pk * bf2f(WSP(bf16, WS_VA)[((size_t)b * SEQ + kp) * 128 + hk * 64 + lane]); }
        WSP(bf16, WS_MIX)[row * DM + head * 64 + lane] = (bf16)f2bf(o / l);
    }
}
__device__ __forceinline__ void naive_mla(Frame& F) {
    const int gw = F.vcu * NWAVES + F.wave, NGW = F.G * NWAVES, lane = F.lane;
    LAS float* sc = (LAS float*)(F.lds + RING_OFF) + F.wave * 4096;
    LAS float* qf = (LAS float*)(F.lds + LDS_EXTRA_OFF) + F.wave * 192;
    for (int t = gw; t < NB * 8 * (SEQ / 2); t += NGW) {
        const int j = t % (SEQ / 2), bh = t / (SEQ / 2), b = bh >> 3, h = bh & 7;
        for (int pass = 0; pass < 2; ++pass) {
            const int pos = pass ? SEQ - 1 - j : j; const size_t row = (size_t)b * SEQ + pos;
            for (int d = lane; d < 192; d += 64) qf[d] = bf2f(WSP(bf16, WS_QB)[row * NQB + h * 192 + d]);
            LDS_WAIT(); asm volatile("" ::: "memory");
            float mx = -INFINITY;
            for (int kp = lane; kp <= pos; kp += 64) {
                const size_t kr = (size_t)b * SEQ + kp; float a = 0.f;
                for (int d = 0; d < 128; d += 8) { const bf16x8 kv = *(const GAS bf16x8*)(WSP(bf16, WS_KN) + kr * 1024 + h * 128 + d);
#pragma unroll
                    for (int e = 0; e < 8; ++e) a += bf2f((unsigned short)kv[e]) * qf[d + e]; }
                for (int d = 0; d < 64; d += 8) { const bf16x8 kv = *(const GAS bf16x8*)(WSP(bf16, WS_KR) + kr * 64 + d);
#pragma unroll
                    for (int e = 0; e < 8; ++e) a += bf2f((unsigned short)kv[e]) * qf[128 + d + e]; }
                sc[kp] = a; mx = fmaxf(mx, a);
            }
            mx = wave_max(mx);
            float ls = 0.f;
            for (int kp = lane; kp <= pos; kp += 64) { const float p = __builtin_amdgcn_exp2f(sc[kp] - mx); sc[kp] = p; ls += p; }
            ls = wave_sum(ls);
            LDS_WAIT(); asm volatile("" ::: "memory");
            float o0 = 0.f, o1 = 0.f;
            for (int kp = 0; kp <= pos; ++kp) { const float p = sc[kp]; const unsigned vv = *(const GAS unsigned*)(WSP(bf16, WS_VB) + ((size_t)b * SEQ + kp) * 1024 + h * 128 + 2 * lane);
                o0 += p * bf2f(vv & 0xffffu); o1 += p * bf2f(vv >> 16); }
            *(GAS unsigned*)(WSP(bf16, WS_MIX) + row * DM + 1024 + h * 128 + 2 * lane) = pk2(o0 / ls, o1 / ls);
            LDS_WAIT(); asm volatile("" ::: "memory");
        }
    }
}

namespace att {
typedef short s16x4 __attribute__((ext_vector_type(4)));
typedef float f32x16 __attribute__((ext_vector_type(16)));
typedef LAS char* lptr;
#define SBAR() __builtin_amdgcn_sched_barrier(0)
__device__ __forceinline__ int crow(int r, int hi) { return (r & 3) + 8 * (r >> 2) + 4 * hi; }
__device__ __forceinline__ unsigned cvtpk(float lo, float hi) { unsigned r; asm volatile("v_cvt_pk_bf16_f32 %0, %1, %2" : "=v"(r) : "v"(lo), "v"(hi)); return r; }
template <int NCB> __device__ __forceinline__ int v_st(int k, int c) { const int kk = (k & ~0xC) | ((k & 4) << 1) | ((k & 8) >> 1); return ((kk >> 3) * NCB + (c >> 5)) * 512 + ((kk & 7) * 32 + (c & 31)) * 2; }
__device__ __forceinline__ int v_rd_base(int lane) { return ((lane & 3) << 3) | (((lane >> 2) & 3) << 6) | (((lane >> 4) & 1) << 5) | (((lane >> 5) & 1) << 8); }
#define PK4(P, B_, OUT) do { unsigned a0 = cvtpk(P[B_+0], P[B_+1]), a1 = cvtpk(P[B_+2], P[B_+3]); unsigned b0 = cvtpk(P[B_+4], P[B_+5]), b1 = cvtpk(P[B_+6], P[B_+7]); \
        auto r0 = __builtin_amdgcn_permlane32_swap(a0, b0, false, false); auto r1 = __builtin_amdgcn_permlane32_swap(a1, b1, false, false); \
        v4u w = {r0[0], r1[0], r0[1], r1[1]}; OUT = __builtin_bit_cast(bf16x8, w); } while (0)
#define TRRD(dst, base, off) asm volatile("ds_read_b64_tr_b16 %0, %1 offset:%2" : "=&v"(dst) : "v"(base), "i"(off) : "memory")
#define BF8(l, h) ((bf16x8){l[0], l[1], l[2], l[3], h[0], h[1], h[2], h[3]})

constexpr int QBLK = 32, KVBLK = 64, QB = 256;
constexpr int SHM_V = KVBLK * 128 * 2, SHM_KN = KVBLK * 128 * 2, SHM_KR = KVBLK * 64 * 2, SHM_K = SHM_KN + SHM_KR;
constexpr int MLA_QR = 2 * SHM_V + 2 * SHM_K + NWAVES * 64 * 4;
constexpr int MLA_LDS = MLA_QR + QB * 64 * 2;
constexpr float THR = 8.f;
#define KSWZ(row, colB) ((row) * 256 + ((colB) ^ (((row) & 7) << 4)))
__device__ __forceinline__ void mask_causal(f32x16& p0, f32x16& p1, int dq) {
    const float NEG = -__builtin_inff();
#pragma unroll
    for (int r = 0; r < 16; ++r) { const int c = (r & 3) + 8 * (r >> 2); if (dq - c < 0) p0[r] = NEG; if (dq - c - 32 < 0) p1[r] = NEG; }
}
__device__ __forceinline__ void partialSM(f32x16& p0, f32x16& p1, float& m_reg, float& mn, float& alpha) {
    float pmax = p0[0];
#pragma unroll
    for (int r = 1; r < 16; ++r) pmax = fmaxf(pmax, p0[r]);
#pragma unroll
    for (int r = 0; r < 16; ++r) pmax = fmaxf(pmax, p1[r]);
    { auto rr = __builtin_amdgcn_permlane32_swap(__float_as_uint(pmax), __float_as_uint(pmax), false, false); pmax = fmaxf(__uint_as_float(rr[0]), __uint_as_float(rr[1])); }
    if (__builtin_expect(__all(pmax - m_reg <= THR), 1)) { mn = m_reg; alpha = 1.f; }
    else { mn = fmaxf(m_reg, pmax); alpha = __builtin_amdgcn_exp2f(m_reg - mn); m_reg = mn; }
#pragma unroll
    for (int r = 0; r < 16; ++r) p0[r] -= mn;
#pragma unroll
    for (int r = 0; r < 16; ++r) p1[r] -= mn;
#pragma unroll
    for (int r = 0; r < 16; ++r) p0[r] = __builtin_amdgcn_exp2f(p0[r]);
}
__device__ __forceinline__ void finishSM(f32x16& p0, f32x16& p1, float alpha, float& l_reg, bf16x8& pa0, bf16x8& pa1, bf16x8& pa2, bf16x8& pa3) {
#pragma unroll
    for (int r = 0; r < 16; ++r) p1[r] = __builtin_amdgcn_exp2f(p1[r]);
    float ps = 0;
#pragma unroll
    for (int r = 0; r < 16; ++r) ps += p0[r];
#pragma unroll
    for (int r = 0; r < 16; ++r) ps += p1[r];
    { auto rr = __builtin_amdgcn_permlane32_swap(__float_as_uint(ps), __float_as_uint(ps), false, false); ps = __uint_as_float(rr[0]) + __uint_as_float(rr[1]); }
    l_reg = l_reg * alpha + ps;
    PK4(p0, 0, pa0); PK4(p0, 8, pa1); PK4(p1, 0, pa2); PK4(p1, 8, pa3);
}
template <int KB> __device__ __forceinline__ void qkt(f32x16& p0, f32x16& p1, lptr K_lds, int r32, int hi, const bf16x8* qr, lptr qrl) {
    p0 = f32x16{}; p1 = f32x16{};
    lptr kb[4];
#pragma unroll
    for (int dd = 0; dd < 4; ++dd) kb[dd] = K_lds + KB * SHM_K + KSWZ(r32, (dd * 16 + hi * 8) * 2);
#pragma unroll
    for (int d0 = 0; d0 < 8; ++d0) { lptr a = kb[d0 & 3] + (d0 >> 2) * 128;
        const bf16x8 b0 = *(const LAS bf16x8*)a, b1 = *(const LAS bf16x8*)(a + 32 * 256);
        p0 = __builtin_amdgcn_mfma_f32_32x32x16_bf16(b0, qr[d0], p0, 0, 0, 0);
        p1 = __builtin_amdgcn_mfma_f32_32x32x16_bf16(b1, qr[d0], p1, 0, 0, 0); }
    lptr kr = K_lds + KB * SHM_K + SHM_KN + r32 * 128;
#pragma unroll
    for (int d1 = 0; d1 < 4; ++d1) { lptr a = kr + (((2 * d1 + hi) ^ (r32 & 7)) << 4);
        const bf16x8 b0 = *(const LAS bf16x8*)a, b1 = *(const LAS bf16x8*)(a + 32 * 128), qv = *(const LAS bf16x8*)(qrl + (((2 * d1 + hi) ^ (r32 & 7)) << 4));
        p0 = __builtin_amdgcn_mfma_f32_32x32x16_bf16(b0, qv, p0, 0, 0, 0);
        p1 = __builtin_amdgcn_mfma_f32_32x32x16_bf16(b1, qv, p1, 0, 0, 0); }
}
template <int VB> __device__ __forceinline__ void pv_tile(f32x16* o, int vb0, bf16x8 pa0, bf16x8 pa1, bf16x8 pa2, bf16x8 pa3) {
#define PV_D0(d0) do { s16x4 l0, l1, l2, l3, h0, h1, h2, h3; constexpr int b_ = VB * SHM_V + (d0) * 512; \
        TRRD(l0, vb0, b_); TRRD(h0, vb0, b_ + 2048); TRRD(l1, vb0, b_ + 4096); TRRD(h1, vb0, b_ + 6144); TRRD(l2, vb0, b_ + 8192); TRRD(h2, vb0, b_ + 10240); TRRD(l3, vb0, b_ + 12288); TRRD(h3, vb0, b_ + 14336); \
        asm volatile("s_waitcnt lgkmcnt(0)" ::: "memory"); SBAR(); \
        o[d0] = __builtin_amdgcn_mfma_f32_32x32x16_bf16(pa0, BF8(l0, h0), o[d0], 0, 0, 0); \
        o[d0] = __builtin_amdgcn_mfma_f32_32x32x16_bf16(pa1, BF8(l1, h1), o[d0], 0, 0, 0); \
        o[d0] = __builtin_amdgcn_mfma_f32_32x32x16_bf16(pa2, BF8(l2, h2), o[d0], 0, 0, 0); \
        o[d0] = __builtin_amdgcn_mfma_f32_32x32x16_bf16(pa3, BF8(l3, h3), o[d0], 0, 0, 0); } while (0)
    PV_D0(0); PV_D0(1); PV_D0(2); PV_D0(3);
#undef PV_D0
}
__device__ __forceinline__ void mla_unit(const bf16* Qp, const bf16* KNp, const bf16* KRp, const bf16* Vp, bf16* Op, int q0, lptr lds) {
    int tid_ = threadIdx.x; asm volatile("" : "+v"(tid_));
    const int tid = tid_, wid = __builtin_amdgcn_readfirstlane(tid >> 6), lane = tid & 63, r32 = lane & 31, hi = lane >> 5;
    const int NT = (q0 + QB) / KVBLK;
    const int qlo = q0 + wid * QBLK, qm = qlo + r32 - 4 * hi;
    lptr V_lds = lds; lptr K_lds = lds + 2 * SHM_V;
    LAS float* ws = (LAS float*)(lds + 2 * SHM_V + 2 * SHM_K) + wid * 64; LAS float* li_l = ws; LAS float* al_l = ws + 32;
    float m_reg = -1e30f, l_reg = 0; f32x16 o[4] = {};
    const int sr = tid >> 4, sc = (tid & 15) * 8, vst0 = v_st<4>(sr, sc), vst1 = v_st<4>(32 + sr, sc), kws = KSWZ(sr, sc * 2);
    const int rr = tid >> 3, rc = (tid & 7) * 8, krs = SHM_KN + rr * 128 + ((rc * 2) ^ ((rr & 7) << 4));
    const int vb0 = (int)(unsigned)(uintptr_t)V_lds + v_rd_base(lane);
    bf16x8 qr[8];
#pragma unroll
    for (int d0 = 0; d0 < 8; ++d0) qr[d0] = *(const GAS bf16x8*)(Qp + (unsigned)((wid * QBLK + r32) * NQB + d0 * 16 + hi * 8));
    lptr qrl = lds + MLA_QR + (wid * QBLK + r32) * 128;
#pragma unroll
    for (int d1 = 0; d1 < 4; ++d1) *(LAS bf16x8*)(qrl + (((2 * d1 + hi) ^ (r32 & 7)) << 4)) = *(const GAS bf16x8*)(Qp + (unsigned)((wid * QBLK + r32) * NQB + 128 + d1 * 16 + hi * 8));
    bf16x8 st_v0, st_v1, st_k0, st_k1, st_k2;
#define VMW() asm volatile("s_waitcnt vmcnt(0)" ::: "memory")
#define SLOAD(k0) do { st_v0 = *(const GAS bf16x8*)(Vp + (unsigned)(((k0) + sr) * 1024 + sc)); st_v1 = *(const GAS bf16x8*)(Vp + (unsigned)(((k0) + 32 + sr) * 1024 + sc)); \
        st_k0 = *(const GAS bf16x8*)(KNp + (unsigned)(((k0) + sr) * 1024 + sc)); st_k1 = *(const GAS bf16x8*)(KNp + (unsigned)(((k0) + 32 + sr) * 1024 + sc)); \
        st_k2 = *(const GAS bf16x8*)(KRp + (unsigned)(((k0) + rr) * 64 + rc)); } while (0)
#define SWRITE(bf) do { *(LAS bf16x8*)(V_lds + (bf) * SHM_V + vst0) = st_v0; *(LAS bf16x8*)(V_lds + (bf) * SHM_V + vst1) = st_v1; \
        *(LAS bf16x8*)(K_lds + (bf) * SHM_K + kws) = st_k0; *(LAS bf16x8*)(K_lds + (bf) * SHM_K + kws + 32 * 256) = st_k1; *(LAS bf16x8*)(K_lds + (bf) * SHM_K + krs) = st_k2; } while (0)
#define RESC(a) do { if (__any((a) < 1.f)) { if (hi == 0) al_l[r32] = (a); asm volatile("s_waitcnt lgkmcnt(0)" ::: "memory"); \
        _Pragma("unroll") for (int d_ = 0; d_ < 4; ++d_) _Pragma("unroll") for (int r = 0; r < 16; ++r) o[d_][r] *= al_l[crow(r, hi)]; } } while (0)
#define KBASE(t) ((t) * KVBLK)
#define MASKT(P0_, P1_, t) do { const int kb_ = KBASE(t); if (kb_ + KVBLK - 1 > qlo) mask_causal(P0_, P1_, qm - kb_); } while (0)
    f32x16 pA0, pA1; float mnA, alA; bf16x8 pa0, pa1, pa2, pa3;
    SLOAD(0); VMW(); SWRITE(0); SBAR();
    SLOAD(KBASE(1));
    __syncthreads();
    SBAR(); qkt<0>(pA0, pA1, K_lds, r32, hi, qr, qrl);
    MASKT(pA0, pA1, 0); partialSM(pA0, pA1, m_reg, mnA, alA);
    VMW(); SWRITE(1);
    __syncthreads();
#define HALF_STEP(t, KB, VB, SB) do { \
        SBAR(); finishSM(pA0, pA1, alA, l_reg, pa0, pa1, pa2, pa3); SBAR(); \
        qkt<KB>(pA0, pA1, K_lds, r32, hi, qr, qrl); SBAR(); \
        SLOAD(KBASE((t) + 1)); SBAR(); \
        pv_tile<VB>(o, vb0, pa0, pa1, pa2, pa3); MASKT(pA0, pA1, (t)); partialSM(pA0, pA1, m_reg, mnA, alA); \
        __syncthreads(); \
        VMW(); SWRITE(SB); \
        RESC(alA); __syncthreads(); } while (0)
    for (int t = 1; t + 1 < NT; t += 2) {
        HALF_STEP(t, 1, 0, 0);
        HALF_STEP(t + 1, 0, 1, 1);
    }
    SBAR(); finishSM(pA0, pA1, alA, l_reg, pa0, pa1, pa2, pa3); SBAR();
    qkt<1>(pA0, pA1, K_lds, r32, hi, qr, qrl); SBAR();
    pv_tile<0>(o, vb0, pa0, pa1, pa2, pa3);
    MASKT(pA0, pA1, NT - 1); partialSM(pA0, pA1, m_reg, mnA, alA); __syncthreads(); RESC(alA);
    finishSM(pA0, pA1, alA, l_reg, pa0, pa1, pa2, pa3); SBAR(); pv_tile<1>(o, vb0, pa0, pa1, pa2, pa3);
    if (hi == 0) li_l[r32] = l_reg;
    __syncthreads();
    { int r32e = r32, hie = hi, lane_e = lane; asm volatile("" : "+v"(r32e), "+v"(hie), "+v"(lane_e));
      LAS bf16* stg = (LAS bf16*)lds + wid * 4096;
#pragma unroll
      for (int r = 0; r < 16; ++r) { const int orow = crow(r, hie); const float rl = __builtin_amdgcn_rcpf(li_l[orow]);
#pragma unroll
          for (int d0 = 0; d0 < 4; ++d0) stg[orow * 128 + d0 * 32 + r32e] = (bf16)f2bf(o[d0][r] * rl); }
      asm volatile("s_waitcnt lgkmcnt(0)" ::: "memory");
      bf16* Ow = Op + (unsigned)(wid * QBLK) * DM;
      const int lr = lane_e >> 4, lc = (lane_e & 15) * 8;
#pragma unroll
      for (int i = 0; i < 8; ++i) { const int row = i * 4 + lr; const v4u v = *(const LAS v4u*)(stg + row * 128 + lc); *(GAS v4u*)(Ow + (unsigned)(row * DM + lc)) = v; } }
    __syncthreads();
#undef VMW
#undef SLOAD
#undef SWRITE
#undef RESC
#undef KBASE
#undef MASKT
#undef HALF_STEP
}

constexpr int SWA_K = 0, SWA_V = 32768, SWA_B = 65536, SWA_L = SWA_B + NWAVES * 512, SWA_LDS = SWA_L + NWAVES * 128;
__device__ __forceinline__ void swa_unit(const bf16* QA, const bf16* KA, const bf16* VA, const float* BIAS, const float* sinks, bf16* MIX, int b, int hk, int n, lptr lds) {
    int tid_ = threadIdx.x; asm volatile("" : "+v"(tid_));
    const int tid = tid_, wid = __builtin_amdgcn_readfirstlane(tid >> 6), lane = tid & 63, r32 = lane & 31, hi = lane >> 5;
    const int head = hk * 8 + wid;
    lptr K_lds = lds + SWA_K; lptr V_lds = lds + SWA_V;
    LAS float* bl = (LAS float*)(lds + SWA_B) + wid * 128; LAS float* ll = (LAS float*)(lds + SWA_L) + wid * 32;
#pragma unroll
    for (int i = 0; i < 4; ++i) { const int idx = tid + 512 * i, row = idx >> 3, ch = idx & 7, kpos = 128 * (n - 1) + row;
        bf16x8 kv = {0, 0, 0, 0, 0, 0, 0, 0}, vv = {0, 0, 0, 0, 0, 0, 0, 0};
        if (kpos >= 0) { const unsigned off = (unsigned)((b * SEQ + kpos) * 128 + hk * 64 + ch * 8); kv = *(const GAS bf16x8*)(KA + off); vv = *(const GAS bf16x8*)(VA + off); }
        *(LAS bf16x8*)(K_lds + row * 128 + ((ch ^ (row & 7)) << 4)) = kv;
        *(LAS bf16x8*)(V_lds + v_st<2>(row, ch * 8)) = vv; }
    bl[lane] = BIAS[head * 128 + lane]; bl[lane + 64] = BIAS[head * 128 + lane + 64];
    __syncthreads();
    const float sink2 = sinks[head] * LOG2E;
    const int vb = (int)(unsigned)(uintptr_t)V_lds + v_rd_base(lane);
    const float NEG = -__builtin_inff();
    for (int i = 0; i < 4; ++i) {
        const bf16* qrow = QA + (unsigned)((b * SEQ + 128 * n + 32 * i + r32) * 1024 + head * 64 + hi * 8);
        bf16x8 qr[4];
#pragma unroll
        for (int d0 = 0; d0 < 4; ++d0) qr[d0] = *(const GAS bf16x8*)(qrow + d0 * 16);
        f32x16 p[5];
#pragma unroll
        for (int jj = 0; jj < 5; ++jj) { p[jj] = f32x16{}; const int krow = 32 * (i + jj) + r32; lptr kr = K_lds + krow * 128;
#pragma unroll
            for (int d0 = 0; d0 < 4; ++d0) { const bf16x8 a = *(const LAS bf16x8*)(kr + (((2 * d0 + hi) ^ (krow & 7)) << 4)); p[jj] = __builtin_amdgcn_mfma_f32_32x32x16_bf16(a, qr[d0], p[jj], 0, 0, 0); } }
        float mx = sink2;
#pragma unroll
        for (int jj = 0; jj < 5; ++jj) { const bool kvalid = (n > 0) || (i + jj >= 4);
#pragma unroll
            for (int r = 0; r < 16; ++r) { const int dist = 128 + r32 - 32 * jj - crow(r, hi); const bool ok = kvalid && dist >= 0 && dist < 128;
                const float s = ok ? p[jj][r] + bl[dist & 127] : NEG; p[jj][r] = s; mx = fmaxf(mx, s); } }
        { auto rr_ = __builtin_amdgcn_permlane32_swap(__float_as_uint(mx), __float_as_uint(mx), false, false); mx = fmaxf(__uint_as_float(rr_[0]), __uint_as_float(rr_[1])); }
        float ls = 0.f;
#pragma unroll
        for (int jj = 0; jj < 5; ++jj)
#pragma unroll
            for (int r = 0; r < 16; ++r) { const float e = __builtin_amdgcn_exp2f(p[jj][r] - mx); p[jj][r] = e; ls += e; }
        { auto rr_ = __builtin_amdgcn_permlane32_swap(__float_as_uint(ls), __float_as_uint(ls), false, false); ls = __uint_as_float(rr_[0]) + __uint_as_float(rr_[1]); }
        ls += __builtin_amdgcn_exp2f(sink2 - mx);
        if (hi == 0) ll[r32] = ls;
        bf16x8 pa[10];
#pragma unroll
        for (int jj = 0; jj < 5; ++jj) { PK4(p[jj], 0, pa[2 * jj]); PK4(p[jj], 8, pa[2 * jj + 1]); }
        f32x16 o[2] = {};
        const int vbi = vb + i * 4096;
#pragma unroll
        for (int ks = 0; ks < 10; ++ks)
#pragma unroll
            for (int d0 = 0; d0 < 2; ++d0) { s16x4 l_, h_; TRRD(l_, vbi, d0 * 512 + ks * 2048); TRRD(h_, vbi, d0 * 512 + ks * 2048 + 1024);
                asm volatile("s_waitcnt lgkmcnt(0)" ::: "memory"); SBAR();
                o[d0] = __builtin_amdgcn_mfma_f32_32x32x16_bf16(pa[ks], BF8(l_, h_), o[d0], 0, 0, 0); }
        asm volatile("s_waitcnt lgkmcnt(0)" ::: "memory");
        bf16* Ow = MIX + (unsigned)((b * SEQ + 128 * n + 32 * i) * DM + head * 64);
#pragma unroll
        for (int r = 0; r < 16; ++r) { const int orow = crow(r, hi); const float rl = __builtin_amdgcn_rcpf(ll[orow]);
#pragma unroll
            for (int d0 = 0; d0 < 2; ++d0) { const float v = o[d0][r] * rl; const float vn = __shfl_xor(v, 1);
                if ((r32 & 1) == 0) *(GAS unsigned*)(Ow + (unsigned)(orow * DM + d0 * 32 + r32)) = cvtpk(v, vn); } }
        asm volatile("s_waitcnt lgkmcnt(0)" ::: "memory");
    }
    __syncthreads();
}
#undef SBAR
#undef KSWZ
}

__device__ __forceinline__ void attn_phase(Frame& F) {
    att::lptr lds = (att::lptr)(F.lds + RING_OFF);
    const float* sinks = in_ptr(F, 6);
#if !NAIVE_SWA
    { const int b = F.vcu >> 6, hk = (F.vcu >> 5) & 1, n = F.vcu & 31;
      att::swa_unit(WSP(bf16, WS_QA), WSP(bf16, WS_KA), WSP(bf16, WS_VA), WSP(float, WS_BIAS), sinks, WSP(bf16, WS_MIX), b, hk, n, lds); }
#endif
#if !NAIVE_MLA
    { const int bh = F.vcu >> 3, s = F.vcu & 7, b = bh >> 3, h = bh & 7;
      for (int pass = 0; pass < 2; ++pass) { const int qb = pass ? 15 - s : s, q0 = qb * att::QB;
          att::mla_unit(WSP(bf16, WS_QB) + (size_t)(b * SEQ + q0) * NQB + h * 192, WSP(bf16, WS_KN) + (size_t)b * SEQ * 1024 + h * 128, WSP(bf16, WS_KR) + (size_t)b * SEQ * 64,
                        WSP(bf16, WS_VB) + (size_t)b * SEQ * 1024 + h * 128, WSP(bf16, WS_MIX) + (size_t)(b * SEQ + q0) * DM + 1024 + h * 128, q0, lds); } }
#endif
}

struct Args { const float* in[17]; float* out; unsigned char* ws; int ph_lo, ph_hi, li, pad; };
__global__ void __launch_bounds__(NWAVES * 64, 2) hymba_fwd(Args args) {
    extern __shared__ __attribute__((aligned(16))) unsigned char lds[];
    Frame F;
    F.lds = (LAS unsigned char*)lds;
    F.MISC = (volatile LAS unsigned*)(F.lds + MISC_OFF);
    F.tid = threadIdx.x; F.lane = F.tid & 63; F.wave = __builtin_amdgcn_readfirstlane(F.tid >> 6);
    F.G = gridDim.x; { const int bx = blockIdx.x; F.vcu = (F.G % 8 == 0) ? (bx % 8) * (F.G / 8) + bx / 8 : bx; }
    unsigned char* ws = args.ws;
    F.ctl = (gu32*)(ws + WS_CTL);
    F.out = args.out; F.ws = ws;
    for (int u = F.tid; u < (LDS_EXTRA_OFF - LDSCTL_OFF) / 4; u += NWAVES * 64) ((LAS unsigned*)(F.lds + LDSCTL_OFF))[u] = 0u;
    __syncthreads();
    if (F.tid == 0) { LAS unsigned long long* t = (LAS unsigned long long*)(F.lds + INPTR_OFF);
#pragma unroll
        for (int k = 0; k < 17; ++k) t[k] = (unsigned long long)(uintptr_t)args.in[k]; }
    __syncthreads();
    XcdBarrier bar; bar.bar = (unsigned*)(F.ctl + CW_BAR); bar.x = 0; bar.st = nullptr;
    if (N_LAUNCHES != PER_PHASE) bar = xcd_barrier_post((unsigned*)(F.ctl + CW_BAR), F.MISC + 8);
#define GRID_BAR(seam) do { if (N_LAUNCHES == PER_PHASE) { if (F.tid == 0) __hip_atomic_store(F.ctl + CW_TMO, 0xBADBA0u | (unsigned)(seam), RLX_AGENT); } else { xcd_barrier(bar); } } while (0)
    const int lo = args.ph_lo, hi = args.ph_hi;
#ifndef ONLY_PHASE
#define ONLY_PHASE -1
#endif
#define IN(k) ((ONLY_PHASE < 0 || ONLY_PHASE == (k)) && lo <= (k) && (k) < hi)
#define BOTH(k) (IN(k) && IN((k) + 1))
#ifndef REP_PHASE
#define REP_PHASE -1
#endif
#define REPS(k) for (int rep_ = 0; rep_ < ((REP_PHASE) == (k) ? 2 : 1); ++rep_)
    const bool grid_ok = (F.G == 256);

    if (IN(0)) { REPS(0) { p0_prologue(F); __syncthreads(); } if (BOTH(0)) GRID_BAR(0); }
    if (IN(1)) { REPS(1) { if (grid_ok) norm_mod_phase<true>(F, in_ptr(F, 0), in_ptr(F, 4), 0, 1); __syncthreads(); } if (BOTH(1)) GRID_BAR(1); }
    if (IN(2)) { REPS(2) {
#if NAIVE_GEMM
        EpiIn<true> f{WSP(bf16, WS_QA), WSP(bf16, WS_KA), WSP(bf16, WS_VA), WSP(bf16, WS_CQ), WSP(bf16, WS_CKV), WSP(bf16, WS_KR), WSP(float, WS_SSQ), WSP(float, WS_ROPE)};
        naive_gemm(F, WSP(bf16, WS_XN), WSP(bf16, WS_WIN), M, IN_PAD, DM, f);
#else
        pg8::Gemm g{WSP(bf16, WS_XN), WSP(bf16, WS_WIN), M, IN_PAD, DM}; pg8::StaticOrder S; S.init(M, IN_PAD, F.G, (int)blockIdx.x);
        pg8::EpiRow<EpiIn<false>> E{{WSP(bf16, WS_QA), WSP(bf16, WS_KA), WSP(bf16, WS_VA), WSP(bf16, WS_CQ), WSP(bf16, WS_CKV), WSP(bf16, WS_KR), WSP(float, WS_SSQ), WSP(float, WS_ROPE)}};
        pg8::gemm_phase<pg8::EpiRow<EpiIn<false>>, pg8::StaticOrder, PG8_ALIGN, PG8_SP2>(F.lds + RING_OFF, g, S, E);
#endif
        __syncthreads(); }
        if (BOTH(2)) GRID_BAR(2);
    }
    if (IN(3)) { REPS(3) {
        for (int gi = 0; gi < 2; ++gi) {
            EpiUp f{WSP(bf16, WS_QB), WSP(bf16, WS_KN), WSP(bf16, WS_VB), WSP(float, WS_SSQ), WSP(float, WS_ROPE), gi};
            const bf16* A = gi ? WSP(bf16, WS_CKV) : WSP(bf16, WS_CQ); const bf16* Bt = gi ? WSP(bf16, WS_WUKV) : WSP(bf16, WS_WUQ);
            const int N = gi ? NKVB : NQB, K = gi ? KVRANK : QRANK;
#if NAIVE_GEMM
            naive_gemm(F, A, Bt, M, N, K, f);
#else
            pg8::Gemm g{A, Bt, M, N, K}; pg8::StaticOrder S; S.init(M, N, F.G, (int)blockIdx.x);
            pg8::EpiRow<EpiUp> E{f}; pg8::gemm_phase<pg8::EpiRow<EpiUp>, pg8::StaticOrder, PG8_ALIGN, PG8_SP2>(F.lds + RING_OFF, g, S, E);
#endif
        }
        __syncthreads(); }
        if (BOTH(3)) GRID_BAR(3);
    }
    if (IN(4)) { REPS(4) {
#if NAIVE_SWA
        naive_swa(F);
#endif
#if NAIVE_MLA
        naive_mla(F);
#endif
        __syncthreads();
        if (grid_ok) attn_phase(F);
        __syncthreads(); }
        if (BOTH(4)) GRID_BAR(4);
    }
    if (IN(5)) { REPS(5) {
        EpiRes f{in_ptr(F, 0), F.out, WSP(float, WS_MOD) + 2 * DM};
#if NAIVE_GEMM
        naive_gemm(F, WSP(bf16, WS_MIX), WSP(bf16, WS_WOUT), M, DM, DM, f);
#else
        pg8::Gemm g{WSP(bf16, WS_MIX), WSP(bf16, WS_WOUT), M, DM, DM}; pg8::StaticOrder S; S.init(M, DM, F.G, (int)blockIdx.x);
        pg8::EpiRow<EpiRes> E{f}; pg8::gemm_phase<pg8::EpiRow<EpiRes>, pg8::StaticOrder, PG8_ALIGN, PG8_SP2>(F.lds + RING_OFF, g, S, E);
#endif
        __syncthreads(); }
        if (BOTH(5)) GRID_BAR(5);
    }
    if (IN(6)) { if (grid_ok) norm_mod_phase<false>(F, F.out, in_ptr(F, 13), 3, 4); __syncthreads(); if (BOTH(6)) GRID_BAR(6); }
    if (IN(7)) { REPS(7) {
        EpiRelu2 f{WSP(bf16, WS_H)};
#if NAIVE_GEMM
        naive_gemm(F, WSP(bf16, WS_XN), WSP(bf16, WS_W1), M, FF, DM, f);
#else
        pg8::Gemm g{WSP(bf16, WS_XN), WSP(bf16, WS_W1), M, FF, DM}; pg8::StaticOrder S; S.init(M, FF, F.G, (int)blockIdx.x);
        pg8::EpiRow<EpiRelu2> E{f}; pg8::gemm_phase<pg8::EpiRow<EpiRelu2>, pg8::StaticOrder, PG8_ALIGN, PG8_SP2>(F.lds + RING_OFF, g, S, E);
#endif
        __syncthreads(); }
        if (BOTH(7)) GRID_BAR(7);
    }
    if (IN(8)) {
        EpiRes f{F.out, F.out, WSP(float, WS_MOD) + 5 * DM};
#if NAIVE_GEMM
        naive_gemm(F, WSP(bf16, WS_H), WSP(bf16, WS_W2), M, DM, FF, f);
#else
        pg8::Gemm g{WSP(bf16, WS_H), WSP(bf16, WS_W2), M, DM, FF}; pg8::StaticOrder S; S.init(M, DM, F.G, (int)blockIdx.x);
        pg8::EpiRow<EpiRes> E{f}; pg8::gemm_phase<pg8::EpiRow<EpiRes>, pg8::StaticOrder, PG8_ALIGN, PG8_SP2>(F.lds + RING_OFF, g, S, E);
#endif
        if (BOTH(8)) GRID_BAR(8);
    }
    if (IN(9)) {
        bool bad = !grid_ok || __hip_atomic_load(F.ctl + CW_TMO, RLX_AGENT) != 0u || __hip_atomic_load((gu32*)((unsigned*)(F.ctl + CW_BAR) + XB_TMO), RLX_AGENT) != 0u;
        if (bad) nan_rows_f32(F, F.out); else final_norm_phase(F);
    }
#undef IN
#undef BOTH
}

extern "C" void kernel_launch(void* const* d_in, const int* in_sizes, int n_in, void* d_out, int out_size, void* d_ws, size_t ws_size, hipStream_t stream) {
    static int grid = 0;
    if (grid == 0) {
        if (n_in != 17 || in_sizes[0] != M * DM || out_size != M * DM || ws_size < WS_END) { fprintf(stderr, "kernel_launch: shape mismatch (n_in %d, in0 %d, out %d, ws %zu)\n", n_in, n_in > 0 ? in_sizes[0] : -1, out_size, ws_size); grid = -1; return; }
        int dev = 0, cus = 0;
        if (hipGetDevice(&dev) != hipSuccess || hipDeviceGetAttribute(&cus, hipDeviceAttributeMultiprocessorCount, dev) != hipSuccess) { grid = -1; return; }
        if (hipFuncSetAttribute((const void*)hymba_fwd, hipFuncAttributeMaxDynamicSharedMemorySize, LDS_BYTES) != hipSuccess) { fprintf(stderr, "kernel_launch: hipFuncSetAttribute failed\n"); grid = -1; return; }
        (void)hipGetLastError();
        grid = cus;
        if (grid != 256) fprintf(stderr, "kernel_launch: %d CUs; this kernel is built for 256\n", grid);
    }
    if (grid < 0) return;
    if (hipMemsetAsync((char*)d_ws + WS_CTL, 0, CTL_ZERO_BYTES, stream) != hipSuccess) { fprintf(stderr, "kernel_launch: memset failed\n"); return; }
    Args a{};
    for (int i = 0; i < 17; ++i) a.in[i] = (const float*)d_in[i];
    a.out = (float*)d_out; a.ws = (unsigned char*)d_ws;
    for (int li = 0; li < N_LAUNCHES; ++li) {
        if (N_LAUNCHES == PER_PHASE) { a.ph_lo = li; a.ph_hi = li + 1; } else { a.ph_lo = 0; a.ph_hi = PER_PHASE; }
        a.li = li;
        hipLaunchKernelGGL(hymba_fwd, dim3(grid), dim3(NWAVES * 64), LDS_BYTES, stream, a);
        const hipError_t le = hipPeekAtLastError();
        if (le != hipSuccess) { fprintf(stderr, "kernel_launch: launch %d failed: %s\n", li, hipGetErrorName(le)); break; }
    }
}
```

```cpp
#include <hip/hip_runtime.h>
#include <cstdio>
#include <cstdint>

#ifndef MK_N_LAUNCHES
#define MK_N_LAUNCHES 1
#endif
#ifndef NAIVE_GEMM
#define NAIVE_GEMM 0
#endif
#ifndef NAIVE_SWA
#define NAIVE_SWA 0
#endif
#ifndef NAIVE_MLA
#define NAIVE_MLA 0
#endif

constexpr int NB = 4, SEQ = 4096, DM = 2048, M = NB * SEQ, FF = 8192;
constexpr int IN_COLS = 1856, IN_PAD = 2048;
constexpr int QRANK = 384, KVRANK = 128, NQB = 1536, NKVB = 2048;
constexpr float EPS = 1e-6f;
constexpr float LOG2E = 1.4426950408889634f;
constexpr float CA = 0.125f * LOG2E;
constexpr float C2M = 0.07216878364870322f * LOG2E;
constexpr int OFF_KA = 1024, OFF_VA = 1152, OFF_CQ = 1280, OFF_CKV = 1664, OFF_KR = 1792;

namespace pg8 {
#define PG8_LAS __attribute__((address_space(3)))
typedef unsigned short bf16_t;
typedef short bf16x8 __attribute__((ext_vector_type(8)));
typedef float f32x4 __attribute__((ext_vector_type(4)));
typedef unsigned u32x4 __attribute__((ext_vector_type(4)));
constexpr int BM = 256, BK = 64, HALF = 128, HTB = HALF * BK * 2, STAGE_BYTES = 8 * HTB, NXCD = 8, WGM = 8;

__host__ __device__ __forceinline__ int lds_byte(int r, int c) { const int st = (r >> 4) * 2 + (c >> 5), rr = r & 15, cc = c & 31, ob = rr * 64 + cc * 2; return st * 1024 + (ob ^ (((ob >> 9) & 1) << 5)); }
__host__ __device__ __forceinline__ void stage_rc(int b, int& R, int& C) { const int st = b / 1024, sb = b % 1024, swz = sb ^ (((sb >> 9) & 1) << 5); R = (st >> 1) * 16 + swz / 64; C = (st & 1) * 32 + (swz % 64) / 2; }
__host__ __device__ __forceinline__ int perm32(int rho) { const int n = rho >> 4, i = rho & 15; return 8 * (i >> 2) + 4 * n + (i & 3); }

struct Unit { int pm, pn; };
struct Gemm { const bf16_t* A; const bf16_t* Bt; int M, N, K; };

struct StaticOrder {
    int nM, nN, nwg, G, c;
    __host__ __device__ void init(int M_, int N_, int G_, int c_) { nM = M_ / BM; nN = N_ / BM; nwg = nM * nN; G = G_; c = c_; }
    __host__ __device__ bool next(int i, Unit& u) const {
        const long L = (long)i * G + c; if (L >= nwg) return false;
        int wgid = (int)L; { const int q = nwg / NXCD, r = nwg % NXCD, xcd = wgid % NXCD, off = wgid / NXCD; wgid = (xcd < r ? xcd * (q + 1) : r * (q + 1) + (xcd - r) * q) + off; }
        const int nig = WGM * nN, gid = wgid / nig, fm = gid * WGM, gsz = (nM - fm) < WGM ? (nM - fm) : WGM;
        u.pm = fm + ((wgid % nig) % gsz); u.pn = (wgid % nig) / gsz; return true;
    }
    __device__ __forceinline__ void a_ready(const Unit&) const {}
    __device__ __forceinline__ void done(const Unit&) const {}
};

__device__ __forceinline__ unsigned cvt_pk_bf16(float lo, float hi) { unsigned r; asm volatile("v_cvt_pk_bf16_f32 %0, %1, %2" : "=v"(r) : "v"(lo), "v"(hi)); return r; }

template <class F> struct EpiRow {
    static constexpr bool PERM = true, AFTER_DRAIN = false;
    F f;
    __device__ __forceinline__ void operator()(const f32x4 (&acc)[2][2][4][2], const Unit& u, int wr, int wc, int fr, int fq) const {
        asm volatile("" : "+v"(fr), "+v"(fq));
        const int colb = u.pn * BM + wc * 32 + 8 * fq;
        const bool slots = f.tile_has_slots(u.pn * BM);
#pragma unroll
        for (int ai = 0; ai < 2; ++ai)
#pragma unroll
            for (int m = 0; m < 4; ++m) {
                const int row = u.pm * BM + ai * HALF + wr * 64 + m * 16 + fr;
                const auto rc = f.row_ctx(row);
#pragma unroll
                for (int bj = 0; bj < 2; ++bj) {
#pragma unroll
                    for (int n = 0; n < 1; ++n) f.op8(rc, row, colb + bj * HALF, acc[ai][bj][m][0], acc[ai][bj][m][1]);
                    if constexpr (F::HAS_SLOTS) {
                        if (slots) {
                            const f32x4 a = acc[ai][bj][m][0], b = acc[ai][bj][m][1];
                            float s = (a[0] * a[0] + a[1] * a[1]) + (a[2] * a[2] + a[3] * a[3]) + (b[0] * b[0] + b[1] * b[1]) + (b[2] * b[2] + b[3] * b[3]);
                            s += __shfl_xor(s, 16); s += __shfl_xor(s, 32);
                            if (fq == 0) f.slot_store(row, u.pn * BM + bj * HALF + wc * 32, s);
                        }
                    }
                }
                asm volatile("" ::: "memory");
            }
    }
};

template <class Epi, class Sched, bool ALIGN_EPI = false, bool SP2 = false>
__device__ __forceinline__ void gemm_phase(PG8_LAS unsigned char* lds, const Gemm g, const Sched& S, const Epi& E) {
    int tid_ = threadIdx.x; asm volatile("" : "+v"(tid_));
    const int tid = tid_, wid = __builtin_amdgcn_readfirstlane(tid >> 6), lane = tid & 63, wr = wid >> 2, wc = wid & 3, fr = lane & 15, fq = lane >> 4;
    const int K = g.K, nt = K / BK;
    unsigned voffA[2], voffB[2];
#pragma unroll
    for (int i = 0; i < 2; ++i) { int R, C; stage_rc(tid * 16 + i * 8192, R, C); const int Rb = Epi::PERM ? ((R & ~31) + perm32(R & 31)) : R;
        voffA[i] = (unsigned)(R * K + C) * 2u; voffB[i] = (unsigned)(Rb * K + C) * 2u; }
    const size_t kstep = (size_t)(BK * 2);
    const size_t hstep = (size_t)HALF * K * 2;
    const size_t tstep = 2 * hstep;
    const unsigned ldsw = (unsigned)wid * 1024u;
    const int aoff = lds_byte(wr * 64 + fr, fq * 8), boff = lds_byte(wc * 32 + fr, fq * 8);
#define PG8_SA(b, h) (((b) * 2 + (h)) * HTB)
#define PG8_SB(b, h) ((4 + (b) * 2 + (h)) * HTB)
#define PG8_STAGE(bufoff, gbase, voff) do { _Pragma("unroll") for (int _i = 0; _i < 2; ++_i) \
        __builtin_amdgcn_global_load_lds((const unsigned*)((const char*)(gbase) + (voff)[_i]), (PG8_LAS unsigned*)(lds + (bufoff) + ldsw + _i * 8192), 16, 0, 0); } while (0)
#define PG8_LDA(dst, b, h) do { _Pragma("unroll") for (int m = 0; m < 4; ++m) _Pragma("unroll") for (int k = 0; k < 2; ++k) dst[m][k] = *(const PG8_LAS bf16x8*)(lds + PG8_SA(b, h) + aoff + m * 2048 + k * 1024); } while (0)
#define PG8_LDB(dst, b, h) do { _Pragma("unroll") for (int n = 0; n < 2; ++n) _Pragma("unroll") for (int k = 0; k < 2; ++k) dst[n][k] = *(const PG8_LAS bf16x8*)(lds + PG8_SB(b, h) + boff + n * 2048 + k * 1024); } while (0)
#define PG8_MMA(ai, bj, At, Bt) do { __builtin_amdgcn_s_setprio(1); _Pragma("unroll") for (int m = 0; m < 4; ++m) _Pragma("unroll") for (int n = 0; n < 2; ++n) _Pragma("unroll") for (int k = 0; k < 2; ++k) \
        acc[ai][bj][m][n] = __builtin_amdgcn_mfma_f32_16x16x32_bf16(Bt[n][k], At[m][k], acc[ai][bj][m][n], 0, 0, 0); __builtin_amdgcn_s_setprio(0); } while (0)
#define PG8_WAIT_V(n) asm volatile("s_waitcnt vmcnt(" #n ")" ::: "memory")
#define PG8_WAIT_L(n) asm volatile("s_waitcnt lgkmcnt(" #n ")" ::: "memory")
#define PG8_BAR __builtin_amdgcn_s_barrier()
#define PG8_SCHED __builtin_amdgcn_sched_barrier(0)
    Unit cur, nxt; int ui = 0;
    if (!S.next(0, cur)) return;
    f32x4 acc[2][2][4][2];
#pragma unroll
    for (int a = 0; a < 2; ++a)
#pragma unroll
        for (int b = 0; b < 2; ++b)
#pragma unroll
            for (int m = 0; m < 4; ++m)
#pragma unroll
                for (int n = 0; n < 2; ++n) acc[a][b][m][n] = (f32x4){0.f, 0.f, 0.f, 0.f};
    bf16x8 At[4][2], B0[2][2], B1[2][2];
    const char* cA = (const char*)g.A + (size_t)cur.pm * tstep; const char* cB = (const char*)g.Bt + (size_t)cur.pn * tstep;
    S.a_ready(cur);
    if constexpr (SP2) {
        PG8_STAGE(PG8_SB(0, 0), cB, voffB); PG8_STAGE(PG8_SB(0, 1), cB + hstep, voffB); PG8_STAGE(PG8_SA(0, 0), cA, voffA); PG8_STAGE(PG8_SA(0, 1), cA + hstep, voffA);
        if (wr == 1) PG8_BAR;
        PG8_WAIT_V(2); PG8_BAR;
        PG8_STAGE(PG8_SB(1, 0), cB + kstep, voffB); PG8_STAGE(PG8_SA(1, 0), cA + kstep, voffA); PG8_STAGE(PG8_SB(1, 1), cB + hstep + kstep, voffB);
        PG8_WAIT_V(6); PG8_BAR;
    } else {
        PG8_STAGE(PG8_SB(0, 0), cB, voffB); PG8_STAGE(PG8_SA(0, 0), cA, voffA); PG8_STAGE(PG8_SB(0, 1), cB + hstep, voffB); PG8_STAGE(PG8_SA(0, 1), cA + hstep, voffA);
        if (wr == 1) PG8_BAR;
        PG8_WAIT_V(4); PG8_BAR;
        PG8_STAGE(PG8_SB(1, 0), cB + kstep, voffB); PG8_STAGE(PG8_SA(1, 0), cA + kstep, voffA); PG8_STAGE(PG8_SB(1, 1), cB + hstep + kstep, voffB);
        PG8_WAIT_V(6); PG8_BAR;
    }
    for (;;) {
        const bool has_next = S.next(ui + 1, nxt);
        const char* nA = has_next ? (const char*)g.A + (size_t)nxt.pm * tstep : cA; const char* nB = has_next ? (const char*)g.Bt + (size_t)nxt.pn * tstep : cB;
        for (int t = 0; t < nt; t += 2) {
            const bool last = (t == nt - 2);
            const char* a1 = cA + (size_t)(t + 1) * kstep;
            const char* a2 = last ? nA : cA + (size_t)(t + 2) * kstep; const char* b2 = last ? nB : cB + (size_t)(t + 2) * kstep;
            const char* a3 = a2 + kstep; const char* b3 = b2 + kstep;
            if (last && has_next) S.a_ready(nxt);
            if constexpr (SP2) {
            PG8_LDB(B0, 0, 0); PG8_LDB(B1, 0, 1); PG8_SCHED; PG8_LDA(At, 0, 0); PG8_STAGE(PG8_SA(1, 1), a1 + hstep, voffA);
            PG8_WAIT_V(8); PG8_WAIT_L(0); PG8_BAR; PG8_MMA(0, 0, At, B0); PG8_MMA(0, 1, At, B1); PG8_BAR; PG8_SCHED;
            PG8_LDA(At, 0, 1); PG8_STAGE(PG8_SB(0, 0), b2, voffB); PG8_STAGE(PG8_SB(0, 1), b2 + hstep, voffB); PG8_STAGE(PG8_SA(0, 0), a2, voffA);
            PG8_WAIT_V(8); PG8_WAIT_L(0); PG8_BAR; PG8_MMA(1, 0, At, B0); PG8_MMA(1, 1, At, B1); PG8_BAR; PG8_SCHED;
            PG8_LDB(B0, 1, 0); PG8_LDB(B1, 1, 1); PG8_SCHED; PG8_LDA(At, 1, 0); PG8_STAGE(PG8_SA(0, 1), a2 + hstep, voffA);
            PG8_WAIT_V(8); PG8_WAIT_L(0); PG8_BAR; PG8_MMA(0, 0, At, B0); PG8_MMA(0, 1, At, B1); PG8_BAR; PG8_SCHED;
            PG8_LDA(At, 1, 1); PG8_STAGE(PG8_SB(1, 0), b3, voffB); PG8_STAGE(PG8_SB(1, 1), b3 + hstep, voffB); PG8_STAGE(PG8_SA(1, 0), a3, voffA);
            PG8_WAIT_V(8); PG8_WAIT_L(0); PG8_BAR; PG8_MMA(1, 0, At, B0); PG8_MMA(1, 1, At, B1); PG8_BAR; PG8_SCHED;
            } else {
            PG8_LDB(B0, 0, 0); PG8_SCHED; PG8_LDA(At, 0, 0); PG8_STAGE(PG8_SA(1, 1), a1 + hstep, voffA);
            PG8_WAIT_L(8); PG8_BAR; PG8_WAIT_L(0); PG8_MMA(0, 0, At, B0); PG8_BAR; PG8_SCHED;
            PG8_LDB(B1, 0, 1); PG8_STAGE(PG8_SB(0, 0), b2, voffB);
            PG8_BAR; PG8_WAIT_L(0); PG8_MMA(0, 1, At, B1); PG8_BAR;
            PG8_LDA(At, 0, 1); PG8_STAGE(PG8_SA(0, 0), a2, voffA);
            PG8_BAR; PG8_WAIT_L(0); PG8_MMA(1, 0, At, B0); PG8_BAR; PG8_SCHED;
            PG8_STAGE(PG8_SB(0, 1), b2 + hstep, voffB);
            PG8_WAIT_V(6); PG8_BAR; PG8_MMA(1, 1, At, B1); PG8_BAR;
            PG8_LDB(B0, 1, 0); PG8_SCHED; PG8_LDA(At, 1, 0); PG8_STAGE(PG8_SA(0, 1), a2 + hstep, voffA);
            PG8_WAIT_L(8); PG8_BAR; PG8_WAIT_L(0); PG8_MMA(0, 0, At, B0); PG8_BAR; PG8_SCHED;
            PG8_LDB(B1, 1, 1); PG8_STAGE(PG8_SB(1, 0), b3, voffB);
            PG8_BAR; PG8_WAIT_L(0); PG8_MMA(0, 1, At, B1); PG8_BAR;
            PG8_LDA(At, 1, 1); PG8_STAGE(PG8_SA(1, 0), a3, voffA);
            PG8_BAR; PG8_WAIT_L(0); PG8_MMA(1, 0, At, B0); PG8_BAR; PG8_SCHED;
            PG8_STAGE(PG8_SB(1, 1), b3 + hstep, voffB);
            PG8_WAIT_V(6); PG8_BAR; PG8_MMA(1, 1, At, B1); PG8_BAR;
            }
        }
        if constexpr (ALIGN_EPI) { if (wr == 0) PG8_BAR; }
        if constexpr (!Epi::AFTER_DRAIN) { E(acc, cur, wr, wc, fr, fq); S.done(cur); }
        if (!has_next) break;
#pragma unroll
        for (int a = 0; a < 2; ++a)
#pragma unroll
            for (int b = 0; b < 2; ++b)
#pragma unroll
                for (int m = 0; m < 4; ++m)
#pragma unroll
                    for (int n = 0; n < 2; ++n) acc[a][b][m][n] = (f32x4){0.f, 0.f, 0.f, 0.f};
        cur = nxt; cA = nA; cB = nB; ++ui;
        if constexpr (ALIGN_EPI) { if (wr == 1) PG8_BAR; }
    }
    PG8_WAIT_V(0);
    if constexpr (!ALIGN_EPI) { if (wr == 0) PG8_BAR; }
    PG8_BAR;
#undef PG8_SA
#undef PG8_SB
#undef PG8_STAGE
#undef PG8_LDA
#undef PG8_LDB
#undef PG8_MMA
#undef PG8_WAIT_V
#undef PG8_WAIT_L
#undef PG8_BAR
#undef PG8_SCHED
}
}

#ifndef PG8_SP2
#define PG8_SP2 true
#endif
#ifndef PG8_ALIGN
#define PG8_ALIGN true
#endif

constexpr int NWAVES = 8;
constexpr int N_LAUNCHES = MK_N_LAUNCHES;
constexpr int PER_PHASE = 10;

constexpr size_t MiB = 1u << 20;
constexpr size_t WS_CTL = 0, CTL_ZERO_BYTES = 2 * MiB;
constexpr size_t WS_SSQ = 1 * MiB;
constexpr size_t WS_MOD = 2 * MiB;
constexpr size_t WS_BIAS = 2 * MiB + 512 * 1024;
constexpr size_t WS_ROPE = 3 * MiB;
constexpr size_t WS_PART = 4 * MiB;
constexpr size_t WS_WIN = 8 * MiB;
constexpr size_t WS_WUQ = 16 * MiB;
constexpr size_t WS_WUKV = 18 * MiB;
constexpr size_t WS_WOUT = 20 * MiB;
constexpr size_t WS_W1 = 28 * MiB;
constexpr size_t WS_W2 = 60 * MiB;
constexpr size_t WS_H = 92 * MiB;
constexpr size_t WS_QA = 92 * MiB;
constexpr size_t WS_KA = 124 * MiB;
constexpr size_t WS_VA = 128 * MiB;
constexpr size_t WS_CQ = 132 * MiB;
constexpr size_t WS_CKV = 144 * MiB;
constexpr size_t WS_KR = 148 * MiB;
constexpr size_t WS_QB = 150 * MiB;
constexpr size_t WS_KN = 198 * MiB;
constexpr size_t WS_VB = 230 * MiB;
constexpr size_t WS_MIX = 262 * MiB;
constexpr size_t WS_XN = 348 * MiB;
constexpr size_t WS_END = 412 * MiB;
static_assert(WS_MIX + (size_t)M * DM * 2 <= WS_H + (size_t)M * FF * 2 && WS_H + (size_t)M * FF * 2 <= WS_XN && WS_XN + (size_t)M * DM * 2 <= WS_END, "d_ws map");
constexpr int CW_TMO = 0, CW_CODE = 1;
constexpr int CW_BAR = 4096;

constexpr int RING_OFF = 0, RING_BYTES = 131072;
constexpr int LDSCTL_OFF = RING_BYTES, MISC_OFF = LDSCTL_OFF + 320;
constexpr int LDS_EXTRA_OFF = 132 * 1024;
constexpr int LDS_BYTES = 147456;

#define GAS __attribute__((address_space(1)))
#define LAS __attribute__((address_space(3)))
typedef unsigned short bf16;
typedef unsigned v4u __attribute__((ext_vector_type(4)));
typedef unsigned v2u __attribute__((ext_vector_type(2)));
typedef float f32x4 __attribute__((ext_vector_type(4)));
typedef float f32x2 __attribute__((ext_vector_type(2)));
typedef short bf16x8 __attribute__((ext_vector_type(8)));
typedef GAS unsigned gu32;
#define RLX_AGENT __ATOMIC_RELAXED, __HIP_MEMORY_SCOPE_AGENT
#define LDS_WAIT() asm volatile("s_waitcnt lgkmcnt(0)" ::: "memory")
#define VM_WAIT() asm volatile("s_waitcnt vmcnt(0)" ::: "memory")
__device__ __forceinline__ unsigned f2bf(float f) { unsigned u = __builtin_bit_cast(unsigned, f); return (u + 0x7fffu + ((u >> 16) & 1u)) >> 16; }
__device__ __forceinline__ unsigned pk2(float lo, float hi) { return f2bf(lo) | (f2bf(hi) << 16); }
__device__ __forceinline__ float bf2f(unsigned h) { return __builtin_bit_cast(float, h << 16); }

#define XB_TMO      128
#define XB_XCNT(j)  (256  + 64 * (j))
#define XB_XSUB(j)  (1280 + 64 * (j))
#define XB_XGEN(j)  (2304 + 64 * (j))
#define XB_TOP      3328
#define XB_TOPGEN   3392
#define XCD_BAR_WORDS 3456
#define XB_SPIN_CAP (1u << 18)
__device__ __forceinline__ unsigned xb_ld(unsigned* p)              { return __hip_atomic_load(p, __ATOMIC_RELAXED, __HIP_MEMORY_SCOPE_AGENT); }
__device__ __forceinline__ unsigned xb_add(unsigned* p, unsigned v) { return __hip_atomic_fetch_add(p, v, __ATOMIC_RELAXED, __HIP_MEMORY_SCOPE_AGENT); }
__device__ __forceinline__ unsigned xb_xcc_id() { return (unsigned)__builtin_amdgcn_s_getreg((3 << 11) | 20) & 0xFu; }
#define XB_SPIN(cond, bar) do { unsigned _sp = 0; while (cond) { __builtin_amdgcn_s_sleep(1); \
    if ((++_sp & 255u) == 0u) { if (xb_ld(&(bar)[XB_TMO])) break; if (_sp > XB_SPIN_CAP) { atomicAdd(&(bar)[XB_TMO], 1u); break; } } } } while (0)
struct XcdBarrier { unsigned* bar; unsigned x; volatile LAS unsigned* st; };
__device__ __forceinline__ XcdBarrier xcd_barrier_post(unsigned* bar, volatile LAS unsigned* st) {
    XcdBarrier b; b.bar = bar; b.x = xb_xcc_id(); b.st = st;
    if (threadIdx.x == 0) (void)xb_add(&bar[XB_XCNT(b.x)], 1u);
    return b;
}
__device__ __forceinline__ void xcd_barrier_complete(unsigned* bar, unsigned x, unsigned& nloc, unsigned& nx) {
    const unsigned G = gridDim.x * gridDim.y * gridDim.z;
    unsigned sum, cnt, mine, sp = 0u;
    for (;;) {
        sum = 0u; cnt = 0u; mine = 0u;
#pragma unroll
        for (unsigned j = 0; j < 16; ++j) { const unsigned c = xb_ld(&bar[XB_XCNT(j)]); sum += c; cnt += (c > 0u) ? 1u : 0u; mine = (j == x) ? c : mine; }
        if (sum == G) break;
        __builtin_amdgcn_s_sleep(1);
        if ((++sp & 255u) == 0u) { if (xb_ld(&bar[XB_TMO])) break; if (sp > XB_SPIN_CAP) { atomicAdd(&bar[XB_TMO], 1u); break; } }
    }
    nloc = mine > 0u ? mine : 1u; nx = cnt > 0u ? cnt : 1u;
}
__device__ __forceinline__ void xcd_barrier(const XcdBarrier& b) {
    asm volatile("s_waitcnt vmcnt(0)" ::: "memory");
    __syncthreads();
    if (threadIdx.x == 0) {
        unsigned* bar = b.bar;
        __builtin_amdgcn_s_waitcnt(0);
        unsigned nloc = b.st[0], nx = b.st[1];
        if (nloc == 0u) { xcd_barrier_complete(bar, b.x, nloc, nx); b.st[0] = nloc; b.st[1] = nx; }
        const unsigned old = xb_add(&bar[XB_XSUB(b.x)], 1u);
        const unsigned gen = old / nloc;
        if (old + 1u == (gen + 1u) * nloc) {
            __builtin_amdgcn_fence(__ATOMIC_RELEASE, "agent");
            asm volatile("s_waitcnt vmcnt(0)" ::: "memory");
            const unsigned og = xb_add(&bar[XB_TOP], 1u);
            const unsigned tg = og / nx;
            if (og + 1u == (tg + 1u) * nx) xb_add(&bar[XB_TOPGEN], 1u);
            else XB_SPIN(xb_ld(&bar[XB_TOPGEN]) == tg, bar);
            __builtin_amdgcn_fence(__ATOMIC_ACQUIRE, "agent");
            xb_add(&bar[XB_XGEN(b.x)], 1u);
            asm volatile("s_waitcnt vmcnt(0)" ::: "memory");
        } else {
            XB_SPIN(xb_ld(&bar[XB_XGEN(b.x)]) == gen, bar);
            __builtin_amdgcn_fence(__ATOMIC_ACQUIRE, "agent");
            asm volatile("s_waitcnt vmcnt(0)" ::: "memory");
        }
    }
    __syncthreads();
}

struct Frame {
    LAS unsigned char* lds;
    volatile LAS unsigned* MISC;
    gu32* ctl;
    int tid, lane, wave;
    int vcu, G;
    unsigned char* ws; float* out;
};
constexpr int INPTR_OFF = LDSCTL_OFF + 512;
__device__ __forceinline__ const float* in_ptr(const Frame& F, int k) {
    const unsigned long long v = ((const LAS unsigned long long*)(F.lds + INPTR_OFF))[k];
    const unsigned lo = __builtin_amdgcn_readfirstlane((unsigned)v), hi = __builtin_amdgcn_readfirstlane((unsigned)(v >> 32));
    return (const float*)(((unsigned long long)hi << 32) | lo);
}
#define WSP(T, off) ((T*)(F.ws + (off)))


__device__ __forceinline__ float wave_sum(float v) {
#pragma unroll
    for (int o = 1; o < 64; o <<= 1) v += __shfl_xor(v, o);
    return v;
}
__device__ __forceinline__ float wave_max(float v) {
#pragma unroll
    for (int o = 1; o < 64; o <<= 1) v = fmaxf(v, __shfl_xor(v, o));
    return v;
}

__device__ __forceinline__ int t5_bucket(int n) {
    if (n < 16) return n;
    const unsigned char T[112] = {16,16,16,17,17,18,18,18,19,19,19,20,20,20,20,21,21,21,21,22,22,22,22,22,23,23,23,23,23,23,24,24,24,24,24,24,25,25,25,25,25,25,25,26,26,26,26,26,26,26,26,27,27,27,27,27,27,27,27,27,27,28,28,28,28,28,28,28,28,28,28,29,29,29,29,29,29,29,29,29,29,29,29,30,30,30,30,30,30,30,30,30,30,30,30,30,30,31,31,31,31,31,31,31,31,31,31,31,31,31,31,31};
    return T[n - 16];
}

__device__ __forceinline__ void sincos_acc(float ang, float& s_out, float& c_out) {
    const double x = (double)ang;
    const double k = __builtin_rint(x * 0.15915494309189535);
    double r = __builtin_fma(-k, 6.283185307179586, x); r = __builtin_fma(-k, 2.4492935982947064e-16, r);
    const double y = r * 0.25, y2 = y * y;
    double s = y * (1.0 + y2 * (-1.0 / 6 + y2 * (1.0 / 120 + y2 * (-1.0 / 5040 + y2 * (1.0 / 362880 + y2 * (-1.0 / 39916800 + y2 * (1.0 / 6227020800.0)))))));
    double c = 1.0 + y2 * (-0.5 + y2 * (1.0 / 24 + y2 * (-1.0 / 720 + y2 * (1.0 / 40320 + y2 * (-1.0 / 3628800 + y2 * (1.0 / 479001600.0))))));
    double s2 = 2.0 * s * c, c2 = 1.0 - 2.0 * s * s;
    double s4 = 2.0 * s2 * c2, c4 = 1.0 - 2.0 * s2 * s2;
    s_out = (float)s4; c_out = (float)c4;
}

template <int MODE> __device__ __forceinline__ int dst_row(int n) {
    if (MODE == 1) { if (n >= OFF_KR) { const int j = n - OFF_KR; return OFF_KR + 2 * (j & 31) + (j >> 5); } return n; }
    if (MODE == 2) { const int h = n / 192, w = n - h * 192; if (w >= 128) { const int j = w - 128; return h * 192 + 128 + 2 * (j & 31) + (j >> 5); } return n; }
    return n;
}
struct TrItem { const float* W; bf16* WT; const float* gs; int K, N, mode, k0, n0; };
constexpr int I_IN = (DM / 64) * (IN_COLS / 32), I_UQ = (QRANK / 64) * (NQB / 32), I_UKV = (KVRANK / 64) * (NKVB / 32), I_OUT = (DM / 64) * (DM / 32), I_1 = (DM / 64) * (FF / 32), I_2 = (FF / 64) * (DM / 32);
constexpr int N_ITEMS = I_IN + I_UQ + I_UKV + I_OUT + I_1 + I_2;
__device__ __forceinline__ TrItem tr_item(const Frame& F, int r) {
    TrItem t;
    if (r < I_IN) { t.W = in_ptr(F, 5); t.WT = WSP(bf16, WS_WIN); t.gs = nullptr; t.K = DM; t.N = IN_COLS; t.mode = 1; }
    else if ((r -= I_IN) < I_UQ) { t.W = in_ptr(F, 9); t.WT = WSP(bf16, WS_WUQ); t.gs = in_ptr(F, 8); t.K = QRANK; t.N = NQB; t.mode = 2; }
    else if ((r -= I_UQ) < I_UKV) { t.W = in_ptr(F, 11); t.WT = WSP(bf16, WS_WUKV); t.gs = in_ptr(F, 10); t.K = KVRANK; t.N = NKVB; t.mode = 0; }
    else if ((r -= I_UKV) < I_OUT) { t.W = in_ptr(F, 12); t.WT = WSP(bf16, WS_WOUT); t.gs = nullptr; t.K = DM; t.N = DM; t.mode = 0; }
    else if ((r -= I_OUT) < I_1) { t.W = in_ptr(F, 14); t.WT = WSP(bf16, WS_W1); t.gs = nullptr; t.K = DM; t.N = FF; t.mode = 0; }
    else { r -= I_1; t.W = in_ptr(F, 15); t.WT = WSP(bf16, WS_W2); t.gs = nullptr; t.K = FF; t.N = DM; t.mode = 0; }
    const int nblk = t.N / 32, kb = r / nblk, nb = r - kb * nblk; t.k0 = 64 * kb; t.n0 = 32 * nb;
    return t;
}
__device__ __forceinline__ void tr_load(const TrItem& t, int lane, f32x4 (&v)[8]) {
    const float* p = t.W + (size_t)(t.k0 + (lane >> 3)) * t.N + t.n0 + 4 * (lane & 7);
#pragma unroll
    for (int i = 0; i < 8; ++i) v[i] = *(const GAS f32x4*)(p + (size_t)(8 * i) * t.N);
}
__device__ __forceinline__ void tr_store(const TrItem& t, int lane, const f32x4 (&v)[8], LAS float* scr) {
    { LAS float* w = scr + (lane >> 3) * 33 + 4 * (lane & 7);
#pragma unroll
      for (int i = 0; i < 8; ++i) { w[i * 264 + 0] = v[i][0]; w[i * 264 + 1] = v[i][1]; w[i * 264 + 2] = v[i][2]; w[i * 264 + 3] = v[i][3]; } }
    LDS_WAIT(); asm volatile("" ::: "memory");
    const int c = lane & 7;
    float g[8];
#pragma unroll
    for (int e = 0; e < 8; ++e) g[e] = t.gs ? t.gs[t.k0 + 8 * c + e] : 1.0f;
#pragma unroll
    for (int j = 0; j < 4; ++j) { const int n = (lane >> 3) + 8 * j; const LAS float* s = scr + (8 * c) * 33 + n;
        v4u o; o.x = pk2(s[0 * 33] * g[0], s[1 * 33] * g[1]); o.y = pk2(s[2 * 33] * g[2], s[3 * 33] * g[3]); o.z = pk2(s[4 * 33] * g[4], s[5 * 33] * g[5]); o.w = pk2(s[6 * 33] * g[6], s[7 * 33] * g[7]);
        const int nn = t.n0 + n, dr = t.mode == 1 ? dst_row<1>(nn) : t.mode == 2 ? dst_row<2>(nn) : nn;
        *(GAS v4u*)(t.WT + (size_t)dr * t.K + t.k0 + 8 * c) = o; }
    LDS_WAIT(); asm volatile("" ::: "memory");
}
constexpr int MOD_KS = 16, MOD_N = 6 * DM, MOD_CG = MOD_N / 256;
__device__ __forceinline__ void p0_prologue(Frame& F) {
    LAS float* sil = (LAS float*)(F.lds + RING_OFF);
    LAS float* scr = (LAS float*)(F.lds + RING_OFF + 32768 + F.wave * 8704);
    for (int i = F.tid; i < NB * DM; i += NWAVES * 64) { const float v = in_ptr(F, 1)[i]; sil[i] = v / (1.0f + __expf(-v)); }
    __syncthreads();
    const int gw = F.vcu * NWAVES + F.wave, NGW = F.G * NWAVES, lane = F.lane;
    constexpr int T_MOD = MOD_KS * MOD_CG;
    if (gw < T_MOD) {
        const int cg = gw % MOD_CG, ks = gw / MOD_CG, j0 = cg * 256 + 4 * lane, k0 = ks * (DM / MOD_KS);
        const float* wp = in_ptr(F, 2) + (size_t)k0 * MOD_N + j0;
        f32x4 acc[4] = {{0.f, 0.f, 0.f, 0.f}, {0.f, 0.f, 0.f, 0.f}, {0.f, 0.f, 0.f, 0.f}, {0.f, 0.f, 0.f, 0.f}};
        for (int kk = 0; kk < DM / MOD_KS; kk += 16) {
            f32x4 w[16];
#pragma unroll
            for (int u = 0; u < 16; ++u) w[u] = *(const GAS f32x4*)(wp + (size_t)(kk + u) * MOD_N);
#pragma unroll
            for (int u = 0; u < 16; ++u)
#pragma unroll
                for (int b = 0; b < 4; ++b) acc[b] += sil[b * DM + k0 + kk + u] * w[u];
        }
#pragma unroll
        for (int b = 0; b < 4; ++b) *(GAS f32x4*)(WSP(float, WS_PART) + (size_t)(ks * 4 + b) * MOD_N + j0) = acc[b];
    }
    {
        const int nsl = gw < T_MOD ? 1 : 4, base = gw < T_MOD ? gw : T_MOD + (gw - T_MOD) * 4, SLOTS = T_MOD + (NGW - T_MOD) * 4;
        f32x4 va[8], vb[8];
        int q = 0; int it = base;
        if (it < N_ITEMS) { TrItem ta = tr_item(F, it); tr_load(ta, lane, va);
            for (;;) {
                ++q; const int itn = (q / nsl) * SLOTS + base + (q % nsl); const bool more = itn < N_ITEMS;
                TrItem tb = tr_item(F, more ? itn : it);
                if (more) tr_load(tb, lane, vb);
                tr_store(ta, lane, va, scr);
                if (!more) break;
#pragma unroll
                for (int i = 0; i < 8; ++i) va[i] = vb[i];
                ta = tb; it = itn;
            } }
    }
    constexpr int T_PAD = IN_PAD - IN_COLS, T_ROPE = SEQ * 32 / 64, T_BIAS = 16 * 128 / 64;
    for (int it = gw; it < T_PAD + T_ROPE + T_BIAS; it += NGW) {
        int r = it;
        if (r < T_PAD) {
            GAS v4u* o = (GAS v4u*)(WSP(bf16, WS_WIN) + (size_t)(IN_COLS + r) * DM) + lane;
#pragma unroll
            for (int j = 0; j < 4; ++j) o[64 * j] = (v4u){0u, 0u, 0u, 0u};
            continue;
        }
        r -= T_PAD;
        if (r < T_ROPE) {
            const int pos = 2 * r + (lane >> 5), i = lane & 31;
            double f = 1.0; for (int e = 0; e < i; ++e) f *= 0.7498942093324559;
            const float ang = (float)pos * (float)f;
            float s, c; sincos_acc(ang, s, c);
            *(GAS f32x2*)(WSP(float, WS_ROPE) + ((size_t)pos * 32 + i) * 2) = (f32x2){c, s};
            continue;
        }
        r -= T_ROPE;
        { const int e = r * 64 + lane, head = e >> 7, dist = e & 127;
          WSP(float, WS_BIAS)[e] = in_ptr(F, 7)[t5_bucket(dist) * 16 + head] * LOG2E; }
    }
}

template <bool FROM_PART> __device__ __forceinline__ void norm_mod_phase(Frame& F, const float* xin, const float* gvec, int sh_chunk, int sc_chunk) {
    LAS f32x2* ab = (LAS f32x2*)(F.lds + RING_OFF);
    const int b = F.vcu / (SEQ / 64);
    for (int k = F.tid; k < DM; k += NWAVES * 64) {
        float sc, sh;
        if (FROM_PART) { float a[MOD_KS], c[MOD_KS];
#pragma unroll
            for (int ks = 0; ks < MOD_KS; ++ks) { const float* p = WSP(float, WS_PART) + (size_t)(ks * 4 + b) * MOD_N; a[ks] = p[sc_chunk * DM + k]; c[ks] = p[sh_chunk * DM + k]; }
            sc = in_ptr(F, 3)[sc_chunk * DM + k]; sh = in_ptr(F, 3)[sh_chunk * DM + k];
#pragma unroll
            for (int ks = 0; ks < MOD_KS; ++ks) { sc += a[ks]; sh += c[ks]; } }
        else { sc = WSP(float, WS_MOD)[b * MOD_N + sc_chunk * DM + k]; sh = WSP(float, WS_MOD)[b * MOD_N + sh_chunk * DM + k]; }
        ab[k] = (f32x2){gvec[k] * (1.0f + sc), sh};
    }
    if (FROM_PART) {
        const int o = F.vcu * (NB * MOD_N / 256) + F.tid;
        if (F.tid < NB * MOD_N / 256) { const int bb = o / MOD_N, j = o - bb * MOD_N; float a[MOD_KS];
#pragma unroll
            for (int ks = 0; ks < MOD_KS; ++ks) a[ks] = WSP(float, WS_PART)[(size_t)(ks * 4 + bb) * MOD_N + j];
            float s_ = in_ptr(F, 3)[j];
#pragma unroll
            for (int ks = 0; ks < MOD_KS; ++ks) s_ += a[ks];
            WSP(float, WS_MOD)[o] = s_; }
    }
    __syncthreads();
    for (int i = 0; i < 8; i += 2) {
        const int row = F.vcu * 64 + F.wave * 8 + i;
        const GAS f32x4* xr = (const GAS f32x4*)(xin + (size_t)row * DM) + F.lane;
        f32x4 v[2][8]; float s[2] = {0.f, 0.f};
#pragma unroll
        for (int u = 0; u < 2; ++u)
#pragma unroll
            for (int j = 0; j < 8; ++j) v[u][j] = xr[u * (DM / 4) + 64 * j];
#pragma unroll
        for (int u = 0; u < 2; ++u) {
#pragma unroll
            for (int j = 0; j < 8; ++j) s[u] += (v[u][j].x * v[u][j].x + v[u][j].y * v[u][j].y) + (v[u][j].z * v[u][j].z + v[u][j].w * v[u][j].w);
            const float rstd = 1.0f / sqrtf(wave_sum(s[u]) * (1.0f / DM) + EPS);
            GAS v2u* o8 = (GAS v2u*)(WSP(bf16, WS_XN) + (size_t)(row + u) * DM) + F.lane;
#pragma unroll
            for (int j = 0; j < 8; ++j) { const int k = 4 * (F.lane + 64 * j);
                const f32x2 a0 = ab[k], a1 = ab[k + 1], a2 = ab[k + 2], a3 = ab[k + 3];
                o8[64 * j] = (v2u){pk2(v[u][j].x * rstd * a0.x + a0.y, v[u][j].y * rstd * a1.x + a1.y), pk2(v[u][j].z * rstd * a2.x + a2.y, v[u][j].w * rstd * a3.x + a3.y)}; }
        }
    }
}
__device__ __forceinline__ void final_norm_phase(Frame& F) {
    const int gw = F.vcu * NWAVES + F.wave, NGW = F.G * NWAVES;
    f32x4 g[8];
#pragma unroll
    for (int j = 0; j < 8; ++j) g[j] = *((const GAS f32x4*)in_ptr(F, 16) + F.lane + 64 * j);
    for (int row = gw; row < M; row += 2 * NGW) {
        f32x4 v[2][8];
#pragma unroll
        for (int u = 0; u < 2; ++u) { const GAS f32x4* xr = (const GAS f32x4*)(F.out + (size_t)(row + u * NGW) * DM) + F.lane;
#pragma unroll
            for (int j = 0; j < 8; ++j) v[u][j] = xr[64 * j]; }
#pragma unroll
        for (int u = 0; u < 2; ++u) { float s = 0.f;
#pragma unroll
            for (int j = 0; j < 8; ++j) s += (v[u][j].x * v[u][j].x + v[u][j].y * v[u][j].y) + (v[u][j].z * v[u][j].z + v[u][j].w * v[u][j].w);
            const float rstd = 1.0f / sqrtf(wave_sum(s) * (1.0f / DM) + EPS);
            GAS f32x4* xo = (GAS f32x4*)(F.out + (size_t)(row + u * NGW) * DM) + F.lane;
#pragma unroll
            for (int j = 0; j < 8; ++j) xo[64 * j] = v[u][j] * rstd * g[j]; }
    }
}
__device__ __forceinline__ void nan_rows_f32(Frame& F, float* out) {
    const int gw = F.vcu * NWAVES + F.wave, NGW = F.G * NWAVES; const float q = __builtin_nanf("");
    for (int m = gw; m < M; m += NGW) { GAS f32x4* o = (GAS f32x4*)(out + (size_t)m * DM) + F.lane;
#pragma unroll
        for (int j = 0; j < 8; ++j) o[64 * j] = (f32x4){q, q, q, q}; }
}

struct NoCtx {};
__device__ __forceinline__ void st_bf4(bf16* base, unsigned off, f32x4 v) { *(GAS v2u*)(base + off) = (v2u){pk2(v[0], v[1]), pk2(v[2], v[3])}; }
__device__ __forceinline__ void st_bf8(bf16* base, unsigned off, f32x4 a, f32x4 b) { *(GAS v4u*)(base + off) = (v4u){pk2(a[0], a[1]), pk2(a[2], a[3]), pk2(b[0], b[1]), pk2(b[2], b[3])}; }
__device__ __forceinline__ f32x4 rope4(const float* ROPE, unsigned pos, unsigned p, f32x4 v) {
    const f32x4 cs = *(const GAS f32x4*)(ROPE + (pos * 64u + p));
    return (f32x4){v[0] * cs[0] - v[1] * cs[1], v[1] * cs[0] + v[0] * cs[1], v[2] * cs[2] - v[3] * cs[3], v[3] * cs[2] + v[2] * cs[3]};
}
template <bool ATOMIC> struct EpiIn {
    static constexpr bool HAS_SLOTS = true;
    bf16 *QA, *KA, *VA, *CQ, *CKV, *KR; float* SSQ; const float* ROPE;
    __device__ __forceinline__ bool tile_has_slots(int col0) const { return !ATOMIC && col0 >= OFF_CQ && col0 < OFF_KR; }
    __device__ __forceinline__ NoCtx row_ctx(int) const { return NoCtx{}; }
    __device__ __forceinline__ void slot_store(int row, int col32, float s) const { if (col32 >= OFF_CQ && col32 < OFF_KR) SSQ[(unsigned)row * 16u + (unsigned)((col32 - OFF_CQ) >> 5)] = s; }
    __device__ __forceinline__ void operator()(NoCtx, int row, int col, f32x4 v) const {
        const int reg = __builtin_amdgcn_readfirstlane(col >> 7);
        const unsigned r = (unsigned)row, c = (unsigned)col;
        if (reg < 8) { st_bf4(QA, r * 1024u + c, v * CA); }
        else if (reg == 8) { st_bf4(KA, r * 128u + (c - OFF_KA), v); }
        else if (reg == 9) { st_bf4(VA, r * 128u + (c - OFF_VA), v); }
        else if (reg < 14) {
            if (reg < 13) st_bf4(CQ, r * QRANK + (c - OFF_CQ), v); else st_bf4(CKV, r * KVRANK + (c - OFF_CKV), v);
            if (ATOMIC) atomicAdd(SSQ + (r * 16u + ((c - OFF_CQ) >> 5)), (v[0] * v[0] + v[1] * v[1]) + (v[2] * v[2] + v[3] * v[3]));
        }
        else if (reg == 14) { if (col < IN_COLS) st_bf4(KR, r * 64u + (c - OFF_KR), rope4(ROPE, r & (SEQ - 1), c - OFF_KR, v)); }
    }
    __device__ __forceinline__ void op8(NoCtx, int row, int col, f32x4 v0, f32x4 v1) const {
        const int reg = __builtin_amdgcn_readfirstlane(col >> 7);
        const unsigned r = (unsigned)row, c = (unsigned)col;
        if (reg < 8) { st_bf8(QA, r * 1024u + c, v0 * CA, v1 * CA); }
        else if (reg == 8) { st_bf8(KA, r * 128u + (c - OFF_KA), v0, v1); }
        else if (reg == 9) { st_bf8(VA, r * 128u + (c - OFF_VA), v0, v1); }
        else if (reg < 13) { st_bf8(CQ, r * QRANK + (c - OFF_CQ), v0, v1); }
        else if (reg == 13) { st_bf8(CKV, r * KVRANK + (c - OFF_CKV), v0, v1); }
        else if (reg == 14) { if (col < IN_COLS) { const unsigned pos = r & (SEQ - 1), p = c - OFF_KR; st_bf8(KR, r * 64u + p, rope4(ROPE, pos, p, v0), rope4(ROPE, pos, p + 4, v1)); } }
    }
};
struct EpiUp {
    static constexpr bool HAS_SLOTS = false;
    bf16 *QB, *KN, *VB; const float* SSQ; const float* ROPE; int mode;
    __device__ __forceinline__ bool tile_has_slots(int) const { return false; }
    __device__ __forceinline__ void slot_store(int, int, float) const {}
    __device__ __forceinline__ float row_ctx(int row) const {
        const GAS f32x4* s = (const GAS f32x4*)(SSQ + (unsigned)row * 16u);
        if (mode == 0) { const f32x4 a = s[0], b = s[1], c = s[2];
            const float t = ((a[0] + a[1]) + (a[2] + a[3])) + ((b[0] + b[1]) + (b[2] + b[3])) + ((c[0] + c[1]) + (c[2] + c[3]));
            return C2M * __builtin_amdgcn_rsqf(t * (1.0f / QRANK) + EPS); }
        const f32x4 a = s[3];
        return __builtin_amdgcn_rsqf(((a[0] + a[1]) + (a[2] + a[3])) * (1.0f / KVRANK) + EPS);
    }
    __device__ __forceinline__ void operator()(float rs, int row, int col, f32x4 v) const {
        if (mode == 0) {
            const int c32 = __builtin_amdgcn_readfirstlane(col >> 5), h = c32 / 6, w32 = c32 - 6 * h;
            if (w32 >= 4) v = rope4(ROPE, (unsigned)row & (SEQ - 1), (unsigned)(col - h * 192 - 128), v);
            st_bf4(QB, (unsigned)row * NQB + (unsigned)col, v * rs);
        } else {
            const int c128 = __builtin_amdgcn_readfirstlane(col >> 7), h = c128 >> 1;
            const unsigned off = (unsigned)row * 1024u + (unsigned)(h * 128 + (col & 127));
            if ((c128 & 1) == 0) st_bf4(KN, off, v * rs); else st_bf4(VB, off, v * rs);
        }
    }
    __device__ __forceinline__ void op8(float rs, int row, int col, f32x4 v0, f32x4 v1) const {
        if (mode == 0) {
            const int c32 = __builtin_amdgcn_readfirstlane(col >> 5), h = c32 / 6, w32 = c32 - 6 * h;
            if (w32 >= 4) { const unsigned pos = (unsigned)row & (SEQ - 1), p = (unsigned)(col - h * 192 - 128); v0 = rope4(ROPE, pos, p, v0); v1 = rope4(ROPE, pos, p + 4, v1); }
            st_bf8(QB, (unsigned)row * NQB + (unsigned)col, v0 * rs, v1 * rs);
        } else {
            const int c128 = __builtin_amdgcn_readfirstlane(col >> 7), h = c128 >> 1;
            const unsigned off = (unsigned)row * 1024u + (unsigned)(h * 128 + (col & 127));
            if ((c128 & 1) == 0) st_bf8(KN, off, v0 * rs, v1 * rs); else st_bf8(VB, off, v0 * rs, v1 * rs);
        }
    }
};
struct EpiRes {
    static constexpr bool HAS_SLOTS = false;
    const float* base; float* out; const float* gate;
    __device__ __forceinline__ bool tile_has_slots(int) const { return false; }
    __device__ __forceinline__ void slot_store(int, int, float) const {}
    __device__ __forceinline__ int row_ctx(int row) const { return __builtin_amdgcn_readfirstlane(row / SEQ); }
    __device__ __forceinline__ void operator()(int b, int row, int col, f32x4 v) const {
        const unsigned off = (unsigned)row * DM + (unsigned)col;
        const f32x4 g = *(const GAS f32x4*)(gate + b * MOD_N + col), x0 = *(const GAS f32x4*)(base + off);
        *(GAS f32x4*)(out + off) = x0 + g * v;
    }
    __device__ __forceinline__ void op8(int b, int row, int col, f32x4 v0, f32x4 v1) const { (*this)(b, row, col, v0); (*this)(b, row, col + 4, v1); }
};
struct EpiRelu2 {
    static constexpr bool HAS_SLOTS = false;
    bf16* H;
    __device__ __forceinline__ bool tile_has_slots(int) const { return false; }
    __device__ __forceinline__ void slot_store(int, int, float) const {}
    __device__ __forceinline__ NoCtx row_ctx(int) const { return NoCtx{}; }
    __device__ __forceinline__ void operator()(NoCtx, int row, int col, f32x4 v) const {
        f32x4 u;
#pragma unroll
        for (int e = 0; e < 4; ++e) { const float t = fmaxf(v[e], 0.f); u[e] = t * t; }
        st_bf4(H, (unsigned)row * FF + (unsigned)col, u);
    }
    __device__ __forceinline__ void op8(NoCtx, int row, int col, f32x4 v0, f32x4 v1) const {
        f32x4 u0, u1;
#pragma unroll
        for (int e = 0; e < 4; ++e) { const float t0 = fmaxf(v0[e], 0.f), t1 = fmaxf(v1[e], 0.f); u0[e] = t0 * t0; u1[e] = t1 * t1; }
        st_bf8(H, (unsigned)row * FF + (unsigned)col, u0, u1);
    }
};

template <class Fn> __device__ __forceinline__ void naive_gemm(Frame& F, const bf16* A, const bf16* Bt, int Mr, int N, int K, const Fn& f) {
    const int gw = F.vcu * NWAVES + F.wave, NGW = F.G * NWAVES, fr = F.lane & 15, fq = F.lane >> 4;
    const int tn = N / 32, ntiles = (Mr / 32) * tn;
    for (int t = gw; t < ntiles; t += NGW) {
        const int row0 = (t / tn) * 32, col0 = (t % tn) * 32;
        f32x4 acc[2][2];
#pragma unroll
        for (int a = 0; a < 2; ++a)
#pragma unroll
            for (int b = 0; b < 2; ++b) acc[a][b] = (f32x4){0.f, 0.f, 0.f, 0.f};
        for (int k = 0; k < K; k += 32) {
            bf16x8 a[2], b[2];
#pragma unroll
            for (int i = 0; i < 2; ++i) { a[i] = *(const GAS bf16x8*)(A + (size_t)(row0 + 16 * i + fr) * K + k + 8 * fq); b[i] = *(const GAS bf16x8*)(Bt + (size_t)(col0 + 16 * i + fr) * K + k + 8 * fq); }
#pragma unroll
            for (int mi = 0; mi < 2; ++mi)
#pragma unroll
                for (int ni = 0; ni < 2; ++ni) acc[mi][ni] = __builtin_amdgcn_mfma_f32_16x16x32_bf16(b[ni], a[mi], acc[mi][ni], 0, 0, 0);
        }
#pragma unroll
        for (int mi = 0; mi < 2; ++mi) { const int row = row0 + 16 * mi + fr; const auto rc = f.row_ctx(row);
#pragma unroll
            for (int ni = 0; ni < 2; ++ni) f(rc, row, col0 + 16 * ni + 4 * fq, acc[mi][ni]); }
    }
}

__device__ __forceinline__ void naive_swa(Frame& F) {
    const int gw = F.vcu * NWAVES + F.wave, NGW = F.G * NWAVES, lane = F.lane;
    for (int t = gw; t < NB * 16 * SEQ; t += NGW) {
        const int pos = t % SEQ, head = (t / SEQ) % 16, b = t / (SEQ * 16), hk = head >> 3;
        const size_t row = (size_t)b * SEQ + pos;
        const bf16* q = WSP(bf16, WS_QA) + row * 1024 + head * 64;
        float sc[2];
#pragma unroll
        for (int u = 0; u < 2; ++u) {
            const int kp = pos - 127 + lane + 64 * u; float s = -INFINITY;
            if (kp >= 0) { const bf16* kr = WSP(bf16, WS_KA) + ((size_t)b * SEQ + kp) * 128 + hk * 64; float a = 0.f;
                for (int d = 0; d < 64; d += 8) { const bf16x8 kv = *(const GAS bf16x8*)(kr + d), qv = *(const GAS bf16x8*)(q + d);
#pragma unroll
                    for (int e = 0; e < 8; ++e) a += bf2f((unsigned short)kv[e]) * bf2f((unsigned short)qv[e]); }
                s = a + WSP(float, WS_BIAS)[head * 128 + (pos - kp)]; }
            sc[u] = s;
        }
        const float sink = in_ptr(F, 6)[head] * LOG2E;
        const float m = fmaxf(wave_max(fmaxf(sc[0], sc[1])), sink);
        const float p0 = __builtin_amdgcn_exp2f(sc[0] - m), p1 = __builtin_amdgcn_exp2f(sc[1] - m);
        const float l = wave_sum(p0 + p1) + __builtin_amdgcn_exp2f(sink - m);
        float o = 0.f;
        for (int kk = 0; kk < 128; ++kk) { const float pk = __shfl(kk < 64 ? p0 : p1, kk & 63); const int kp = pos - 127 + kk;
            if (kp >= 0) o += pk * bf2f(WSP(bf16, WS_VA)[((size_t)b * SEQ + kp) * 128 + hk * 64 + lane]); }
        WSP(bf16, WS_MIX)[row * DM + head * 64 + lane] = (bf16)f2bf(o / l);
    }
}
__device__ __forceinline__ void naive_mla(Frame& F) {
    const int gw = F.vcu * NWAVES + F.wave, NGW = F.G * NWAVES, lane = F.lane;
    LAS float* sc = (LAS float*)(F.lds + RING_OFF) + F.wave * 4096;
    LAS float* qf = (LAS float*)(F.lds + LDS_EXTRA_OFF) + F.wave * 192;
    for (int t = gw; t < NB * 8 * (SEQ / 2); t += NGW) {
        const int j = t % (SEQ / 2), bh = t / (SEQ / 2), b = bh >> 3, h = bh & 7;
        for (int pass = 0; pass < 2; ++pass) {
            const int pos = pass ? SEQ - 1 - j : j; const size_t row = (size_t)b * SEQ + pos;
            for (int d = lane; d < 192; d += 64) qf[d] = bf2f(WSP(bf16, WS_QB)[row * NQB + h * 192 + d]);
            LDS_WAIT(); asm volatile("" ::: "memory");
            float mx = -INFINITY;
            for (int kp = lane; kp <= pos; kp += 64) {
                const size_t kr = (size_t)b * SEQ + kp; float a = 0.f;
                for (int d = 0; d < 128; d += 8) { const bf16x8 kv = *(const GAS bf16x8*)(WSP(bf16, WS_KN) + kr * 1024 + h * 128 + d);
#pragma unroll
                    for (int e = 0; e < 8; ++e) a += bf2f((unsigned short)kv[e]) * qf[d + e]; }
                for (int d = 0; d < 64; d += 8) { const bf16x8 kv = *(const GAS bf16x8*)(WSP(bf16, WS_KR) + kr * 64 + d);
#pragma unroll
                    for (int e = 0; e < 8; ++e) a += bf2f((unsigned short)kv[e]) * qf[128 + d + e]; }
                sc[kp] = a; mx = fmaxf(mx, a);
            }
            mx = wave_max(mx);
            float ls = 0.f;
            for (int kp = lane; kp <= pos; kp += 64) { const float p = __builtin_amdgcn_exp2f(sc[kp] - mx); sc[kp] = p; ls += p; }
            ls = wave_sum(ls);
            LDS_WAIT(); asm volatile("" ::: "memory");
            float o0 = 0.f, o1 = 0.f;
            for (int kp = 0; kp <= pos; ++kp) { const float p = sc[kp]; const unsigned vv = *(const GAS unsigned*)(WSP(bf16, WS_VB) + ((size_t)b * SEQ + kp) * 1024 + h * 128 + 2 * lane);
                o0 += p * bf2f(vv & 0xffffu); o1 += p * bf2f(vv >> 16); }
            *(GAS unsigned*)(WSP(bf16, WS_MIX) + row * DM + 1024 + h * 128 + 2 * lane) = pk2(o0 / ls, o1 / ls);
            LDS_WAIT(); asm volatile("" ::: "memory");
        }
    }
}

namespace att {
typedef short s16x4 __attribute__((ext_vector_type(4)));
typedef float f32x16 __attribute__((ext_vector_type(16)));
typedef LAS char* lptr;
#define SBAR() __builtin_amdgcn_sched_barrier(0)
__device__ __forceinline__ int crow(int r, int hi) { return (r & 3) + 8 * (r >> 2) + 4 * hi; }
__device__ __forceinline__ unsigned cvtpk(float lo, float hi) { unsigned r; asm volatile("v_cvt_pk_bf16_f32 %0, %1, %2" : "=v"(r) : "v"(lo), "v"(hi)); return r; }
template <int NCB> __device__ __forceinline__ int v_st(int k, int c) { const int kk = (k & ~0xC) | ((k & 4) << 1) | ((k & 8) >> 1); return ((kk >> 3) * NCB + (c >> 5)) * 512 + ((kk & 7) * 32 + (c & 31)) * 2; }
__device__ __forceinline__ int v_rd_base(int lane) { return ((lane & 3) << 3) | (((lane >> 2) & 3) << 6) | (((lane >> 4) & 1) << 5) | (((lane >> 5) & 1) << 8); }
#define PK4(P, B_, OUT) do { unsigned a0 = cvtpk(P[B_+0], P[B_+1]), a1 = cvtpk(P[B_+2], P[B_+3]); unsigned b0 = cvtpk(P[B_+4], P[B_+5]), b1 = cvtpk(P[B_+6], P[B_+7]); \
        auto r0 = __builtin_amdgcn_permlane32_swap(a0, b0, false, false); auto r1 = __builtin_amdgcn_permlane32_swap(a1, b1, false, false); \
        v4u w = {r0[0], r1[0], r0[1], r1[1]}; OUT = __builtin_bit_cast(bf16x8, w); } while (0)
#define TRRD(dst, base, off) asm volatile("ds_read_b64_tr_b16 %0, %1 offset:%2" : "=&v"(dst) : "v"(base), "i"(off) : "memory")
#define BF8(l, h) ((bf16x8){l[0], l[1], l[2], l[3], h[0], h[1], h[2], h[3]})

constexpr int QBLK = 32, KVBLK = 64, QB = 256;
constexpr int SHM_V = KVBLK * 128 * 2, SHM_KN = KVBLK * 128 * 2, SHM_KR = KVBLK * 64 * 2, SHM_K = SHM_KN + SHM_KR;
constexpr int MLA_QR = 2 * SHM_V + 2 * SHM_K + NWAVES * 64 * 4;
constexpr int MLA_LDS = MLA_QR + QB * 64 * 2;
constexpr float THR = 8.f;
#define KSWZ(row, colB) ((row) * 256 + ((colB) ^ (((row) & 7) << 4)))
__device__ __forceinline__ void mask_causal(f32x16& p0, f32x16& p1, int dq) {
    const float NEG = -__builtin_inff();
#pragma unroll
    for (int r = 0; r < 16; ++r) { const int c = (r & 3) + 8 * (r >> 2); if (dq - c < 0) p0[r] = NEG; if (dq - c - 32 < 0) p1[r] = NEG; }
}
__device__ __forceinline__ void partialSM(f32x16& p0, f32x16& p1, float& m_reg, float& mn, float& alpha) {
    float pmax = p0[0];
#pragma unroll
    for (int r = 1; r < 16; ++r) pmax = fmaxf(pmax, p0[r]);
#pragma unroll
    for (int r = 0; r < 16; ++r) pmax = fmaxf(pmax, p1[r]);
    { auto rr = __builtin_amdgcn_permlane32_swap(__float_as_uint(pmax), __float_as_uint(pmax), false, false); pmax = fmaxf(__uint_as_float(rr[0]), __uint_as_float(rr[1])); }
    if (__builtin_expect(__all(pmax - m_reg <= THR), 1)) { mn = m_reg; alpha = 1.f; }
    else { mn = fmaxf(m_reg, pmax); alpha = __builtin_amdgcn_exp2f(m_reg - mn); m_reg = mn; }
#pragma unroll
    for (int r = 0; r < 16; ++r) p0[r] -= mn;
#pragma unroll
    for (int r = 0; r < 16; ++r) p1[r] -= mn;
#pragma unroll
    for (int r = 0; r < 16; ++r) p0[r] = __builtin_amdgcn_exp2f(p0[r]);
}
__device__ __forceinline__ void finishSM(f32x16& p0, f32x16& p1, float alpha, float& l_reg, bf16x8& pa0, bf16x8& pa1, bf16x8& pa2, bf16x8& pa3) {
#pragma unroll
    for (int r = 0; r < 16; ++r) p1[r] = __builtin_amdgcn_exp2f(p1[r]);
    float ps = 0;
#pragma unroll
    for (int r = 0; r < 16; ++r) ps += p0[r];
#pragma unroll
    for (int r = 0; r < 16; ++r) ps += p1[r];
    { auto rr = __builtin_amdgcn_permlane32_swap(__float_as_uint(ps), __float_as_uint(ps), false, false); ps = __uint_as_float(rr[0]) + __uint_as_float(rr[1]); }
    l_reg = l_reg * alpha + ps;
    PK4(p0, 0, pa0); PK4(p0, 8, pa1); PK4(p1, 0, pa2); PK4(p1, 8, pa3);
}
template <int KB> __device__ __forceinline__ void qkt(f32x16& p0, f32x16& p1, lptr K_lds, int r32, int hi, const bf16x8* qr, lptr qrl) {
    p0 = f32x16{}; p1 = f32x16{};
    lptr kb[4];
#pragma unroll
    for (int dd = 0; dd < 4; ++dd) kb[dd] = K_lds + KB * SHM_K + KSWZ(r32, (dd * 16 + hi * 8) * 2);
#pragma unroll
    for (int d0 = 0; d0 < 8; ++d0) { lptr a = kb[d0 & 3] + (d0 >> 2) * 128;
        const bf16x8 b0 = *(const LAS bf16x8*)a, b1 = *(const LAS bf16x8*)(a + 32 * 256);
        p0 = __builtin_amdgcn_mfma_f32_32x32x16_bf16(b0, qr[d0], p0, 0, 0, 0);
        p1 = __builtin_amdgcn_mfma_f32_32x32x16_bf16(b1, qr[d0], p1, 0, 0, 0); }
    lptr kr = K_lds + KB * SHM_K + SHM_KN + r32 * 128;
#pragma unroll
    for (int d1 = 0; d1 < 4; ++d1) { lptr a = kr + (((2 * d1 + hi) ^ (r32 & 7)) << 4);
        const bf16x8 b0 = *(const LAS bf16x8*)a, b1 = *(const LAS bf16x8*)(a + 32 * 128), qv = *(const LAS bf16x8*)(qrl + (((2 * d1 + hi) ^ (r32 & 7)) << 4));
        p0 = __builtin_amdgcn_mfma_f32_32x32x16_bf16(b0, qv, p0, 0, 0, 0);
        p1 = __builtin_amdgcn_mfma_f32_32x32x16_bf16(b1, qv, p1, 0, 0, 0); }
}
template <int VB> __device__ __forceinline__ void pv_tile(f32x16* o, int vb0, bf16x8 pa0, bf16x8 pa1, bf16x8 pa2, bf16x8 pa3) {
#define PV_D0(d0) do { s16x4 l0, l1, l2, l3, h0, h1, h2, h3; constexpr int b_ = VB * SHM_V + (d0) * 512; \
        TRRD(l0, vb0, b_); TRRD(h0, vb0, b_ + 2048); TRRD(l1, vb0, b_ + 4096); TRRD(h1, vb0, b_ + 6144); TRRD(l2, vb0, b_ + 8192); TRRD(h2, vb0, b_ + 10240); TRRD(l3, vb0, b_ + 12288); TRRD(h3, vb0, b_ + 14336); \
        asm volatile("s_waitcnt lgkmcnt(0)" ::: "memory"); SBAR(); \
        o[d0] = __builtin_amdgcn_mfma_f32_32x32x16_bf16(pa0, BF8(l0, h0), o[d0], 0, 0, 0); \
        o[d0] = __builtin_amdgcn_mfma_f32_32x32x16_bf16(pa1, BF8(l1, h1), o[d0], 0, 0, 0); \
        o[d0] = __builtin_amdgcn_mfma_f32_32x32x16_bf16(pa2, BF8(l2, h2), o[d0], 0, 0, 0); \
        o[d0] = __builtin_amdgcn_mfma_f32_32x32x16_bf16(pa3, BF8(l3, h3), o[d0], 0, 0, 0); } while (0)
    PV_D0(0); PV_D0(1); PV_D0(2); PV_D0(3);
#undef PV_D0
}
__device__ __forceinline__ void mla_unit(const bf16* Qp, const bf16* KNp, const bf16* KRp, const bf16* Vp, bf16* Op, int q0, lptr lds) {
    int tid_ = threadIdx.x; asm volatile("" : "+v"(tid_));
    const int tid = tid_, wid = __builtin_amdgcn_readfirstlane(tid >> 6), lane = tid & 63, r32 = lane & 31, hi = lane >> 5;
    const int NT = (q0 + QB) / KVBLK;
    const int qlo = q0 + wid * QBLK, qm = qlo + r32 - 4 * hi;
    lptr V_lds = lds; lptr K_lds = lds + 2 * SHM_V;
    LAS float* ws = (LAS float*)(lds + 2 * SHM_V + 2 * SHM_K) + wid * 64; LAS float* li_l = ws; LAS float* al_l = ws + 32;
    float m_reg = -1e30f, l_reg = 0; f32x16 o[4] = {};
    const int sr = tid >> 4, sc = (tid & 15) * 8, vst0 = v_st<4>(sr, sc), vst1 = v_st<4>(32 + sr, sc), kws = KSWZ(sr, sc * 2);
    const int rr = tid >> 3, rc = (tid & 7) * 8, krs = SHM_KN + rr * 128 + ((rc * 2) ^ ((rr & 7) << 4));
    const int vb0 = (int)(unsigned)(uintptr_t)V_lds + v_rd_base(lane);
    bf16x8 qr[8];
#pragma unroll
    for (int d0 = 0; d0 < 8; ++d0) qr[d0] = *(const GAS bf16x8*)(Qp + (unsigned)((wid * QBLK + r32) * NQB + d0 * 16 + hi * 8));
    lptr qrl = lds + MLA_QR + (wid * QBLK + r32) * 128;
#pragma unroll
    for (int d1 = 0; d1 < 4; ++d1) *(LAS bf16x8*)(qrl + (((2 * d1 + hi) ^ (r32 & 7)) << 4)) = *(const GAS bf16x8*)(Qp + (unsigned)((wid * QBLK + r32) * NQB + 128 + d1 * 16 + hi * 8));
    bf16x8 st_v0, st_v1, st_k0, st_k1, st_k2;
#define VMW() asm volatile("s_waitcnt vmcnt(0)" ::: "memory")
#define SLOAD(k0) do { st_v0 = *(const GAS bf16x8*)(Vp + (unsigned)(((k0) + sr) * 1024 + sc)); st_v1 = *(const GAS bf16x8*)(Vp + (unsigned)(((k0) + 32 + sr) * 1024 + sc)); \
        st_k0 = *(const GAS bf16x8*)(KNp + (unsigned)(((k0) + sr) * 1024 + sc)); st_k1 = *(const GAS bf16x8*)(KNp + (unsigned)(((k0) + 32 + sr) * 1024 + sc)); \
        st_k2 = *(const GAS bf16x8*)(KRp + (unsigned)(((k0) + rr) * 64 + rc)); } while (0)
#define SWRITE(bf) do { *(LAS bf16x8*)(V_lds + (bf) * SHM_V + vst0) = st_v0; *(LAS bf16x8*)(V_lds + (bf) * SHM_V + vst1) = st_v1; \
        *(LAS bf16x8*)(K_lds + (bf) * SHM_K + kws) = st_k0; *(LAS bf16x8*)(K_lds + (bf) * SHM_K + kws + 32 * 256) = st_k1; *(LAS bf16x8*)(K_lds + (bf) * SHM_K + krs) = st_k2; } while (0)
#define RESC(a) do { if (__any((a) < 1.f)) { if (hi == 0) al_l[r32] = (a); asm volatile("s_waitcnt lgkmcnt(0)" ::: "memory"); \
        _Pragma("unroll") for (int d_ = 0; d_ < 4; ++d_) _Pragma("unroll") for (int r = 0; r < 16; ++r) o[d_][r] *= al_l[crow(r, hi)]; } } while (0)
#define KBASE(t) ((t) * KVBLK)
#define MASKT(P0_, P1_, t) do { const int kb_ = KBASE(t); if (kb_ + KVBLK - 1 > qlo) mask_causal(P0_, P1_, qm - kb_); } while (0)
    f32x16 pA0, pA1; float mnA, alA; bf16x8 pa0, pa1, pa2, pa3;
    SLOAD(0); VMW(); SWRITE(0); SBAR();
    SLOAD(KBASE(1));
    __syncthreads();
    SBAR(); qkt<0>(pA0, pA1, K_lds, r32, hi, qr, qrl);
    MASKT(pA0, pA1, 0); partialSM(pA0, pA1, m_reg, mnA, alA);
    VMW(); SWRITE(1);
    __syncthreads();
#define HALF_STEP(t, KB, VB, SB) do { \
        SBAR(); finishSM(pA0, pA1, alA, l_reg, pa0, pa1, pa2, pa3); SBAR(); \
        qkt<KB>(pA0, pA1, K_lds, r32, hi, qr, qrl); SBAR(); \
        SLOAD(KBASE((t) + 1)); SBAR(); \
        pv_tile<VB>(o, vb0, pa0, pa1, pa2, pa3); MASKT(pA0, pA1, (t)); partialSM(pA0, pA1, m_reg, mnA, alA); \
        __syncthreads(); \
        VMW(); SWRITE(SB); \
        RESC(alA); __syncthreads(); } while (0)
    for (int t = 1; t + 1 < NT; t += 2) {
        HALF_STEP(t, 1, 0, 0);
        HALF_STEP(t + 1, 0, 1, 1);
    }
    SBAR(); finishSM(pA0, pA1, alA, l_reg, pa0, pa1, pa2, pa3); SBAR();
    qkt<1>(pA0, pA1, K_lds, r32, hi, qr, qrl); SBAR();
    pv_tile<0>(o, vb0, pa0, pa1, pa2, pa3);
    MASKT(pA0, pA1, NT - 1); partialSM(pA0, pA1, m_reg, mnA, alA); __syncthreads(); RESC(alA);
    finishSM(pA0, pA1, alA, l_reg, pa0, pa1, pa2, pa3); SBAR(); pv_tile<1>(o, vb0, pa0, pa1, pa2, pa3);
    if (hi == 0) li_l[r32] = l_reg;
    __syncthreads();
    { int r32e = r32, hie = hi, lane_e = lane; asm volatile("" : "+v"(r32e), "+v"(hie), "+v"(lane_e));
      LAS bf16* stg = (LAS bf16*)lds + wid * 4096;
#pragma unroll
      for (int r = 0; r < 16; ++r) { const int orow = crow(r, hie); const float rl = __builtin_amdgcn_rcpf(li_l[orow]);
#pragma unroll
          for (int d0 = 0; d0 < 4; ++d0) stg[orow * 128 + d0 * 32 + r32e] = (bf16)f2bf(o[d0][r] * rl); }
      asm volatile("s_waitcnt lgkmcnt(0)" ::: "memory");
      bf16* Ow = Op + (unsigned)(wid * QBLK) * DM;
      const int lr = lane_e >> 4, lc = (lane_e & 15) * 8;
#pragma unroll
      for (int i = 0; i < 8; ++i) { const int row = i * 4 + lr; const v4u v = *(const LAS v4u*)(stg + row * 128 + lc); *(GAS v4u*)(Ow + (unsigned)(row * DM + lc)) = v; } }
    __syncthreads();
#undef VMW
#undef SLOAD
#undef SWRITE
#undef RESC
#undef KBASE
#undef MASKT
#undef HALF_STEP
}

constexpr int SWA_K = 0, SWA_V = 32768, SWA_B = 65536, SWA_L = SWA_B + NWAVES * 512, SWA_LDS = SWA_L + NWAVES * 128;
__device__ __forceinline__ void swa_unit(const bf16* QA, const bf16* KA, const bf16* VA, const float* BIAS, const float* sinks, bf16* MIX, int b, int hk, int n, lptr lds) {
    int tid_ = threadIdx.x; asm volatile("" : "+v"(tid_));
    const int tid = tid_, wid = __builtin_amdgcn_readfirstlane(tid >> 6), lane = tid & 63, r32 = lane & 31, hi = lane >> 5;
    const int head = hk * 8 + wid;
    lptr K_lds = lds + SWA_K; lptr V_lds = lds + SWA_V;
    LAS float* bl = (LAS float*)(lds + SWA_B) + wid * 128; LAS float* ll = (LAS float*)(lds + SWA_L) + wid * 32;
#pragma unroll
    for (int i = 0; i < 4; ++i) { const int idx = tid + 512 * i, row = idx >> 3, ch = idx & 7, kpos = 128 * (n - 1) + row;
        bf16x8 kv = {0, 0, 0, 0, 0, 0, 0, 0}, vv = {0, 0, 0, 0, 0, 0, 0, 0};
        if (kpos >= 0) { const unsigned off = (unsigned)((b * SEQ + kpos) * 128 + hk * 64 + ch * 8); kv = *(const GAS bf16x8*)(KA + off); vv = *(const GAS bf16x8*)(VA + off); }
        *(LAS bf16x8*)(K_lds + row * 128 + ((ch ^ (row & 7)) << 4)) = kv;
        *(LAS bf16x8*)(V_lds + v_st<2>(row, ch * 8)) = vv; }
    bl[lane] = BIAS[head * 128 + lane]; bl[lane + 64] = BIAS[head * 128 + lane + 64];
    __syncthreads();
    const float sink2 = sinks[head] * LOG2E;
    const int vb = (int)(unsigned)(uintptr_t)V_lds + v_rd_base(lane);
    const float NEG = -__builtin_inff();
    for (int i = 0; i < 4; ++i) {
        const bf16* qrow = QA + (unsigned)((b * SEQ + 128 * n + 32 * i + r32) * 1024 + head * 64 + hi * 8);
        bf16x8 qr[4];
#pragma unroll
        for (int d0 = 0; d0 < 4; ++d0) qr[d0] = *(const GAS bf16x8*)(qrow + d0 * 16);
        f32x16 p[5];
#pragma unroll
        for (int jj = 0; jj < 5; ++jj) { p[jj] = f32x16{}; const int krow = 32 * (i + jj) + r32; lptr kr = K_lds + krow * 128;
#pragma unroll
            for (int d0 = 0; d0 < 4; ++d0) { const bf16x8 a = *(const LAS bf16x8*)(kr + (((2 * d0 + hi) ^ (krow & 7)) << 4)); p[jj] = __builtin_amdgcn_mfma_f32_32x32x16_bf16(a, qr[d0], p[jj], 0, 0, 0); } }
        float mx = sink2;
#pragma unroll
        for (int jj = 0; jj < 5; ++jj) { const bool kvalid = (n > 0) || (i + jj >= 4);
#pragma unroll
            for (int r = 0; r < 16; ++r) { const int dist = 128 + r32 - 32 * jj - crow(r, hi); const bool ok = kvalid && dist >= 0 && dist < 128;
                const float s = ok ? p[jj][r] + bl[dist & 127] : NEG; p[jj][r] = s; mx = fmaxf(mx, s); } }
        { auto rr_ = __builtin_amdgcn_permlane32_swap(__float_as_uint(mx), __float_as_uint(mx), false, false); mx = fmaxf(__uint_as_float(rr_[0]), __uint_as_float(rr_[1])); }
        float ls = 0.f;
#pragma unroll
        for (int jj = 0; jj < 5; ++jj)
#pragma unroll
            for (int r = 0; r < 16; ++r) { const float e = __builtin_amdgcn_exp2f(p[jj][r] - mx); p[jj][r] = e; ls += e; }
        { auto rr_ = __builtin_amdgcn_permlane32_swap(__float_as_uint(ls), __float_as_uint(ls), false, false); ls = __uint_as_float(rr_[0]) + __uint_as_float(rr_[1]); }
        ls += __builtin_amdgcn_exp2f(sink2 - mx);
        if (hi == 0) ll[r32] = ls;
        bf16x8 pa[10];
#pragma unroll
        for (int jj = 0; jj < 5; ++jj) { PK4(p[jj], 0, pa[2 * jj]); PK4(p[jj], 8, pa[2 * jj + 1]); }
        f32x16 o[2] = {};
        const int vbi = vb + i * 4096;
#pragma unroll
        for (int ks = 0; ks < 10; ++ks)
#pragma unroll
            for (int d0 = 0; d0 < 2; ++d0) { s16x4 l_, h_; TRRD(l_, vbi, d0 * 512 + ks * 2048); TRRD(h_, vbi, d0 * 512 + ks * 2048 + 1024);
                asm volatile("s_waitcnt lgkmcnt(0)" ::: "memory"); SBAR();
                o[d0] = __builtin_amdgcn_mfma_f32_32x32x16_bf16(pa[ks], BF8(l_, h_), o[d0], 0, 0, 0); }
        asm volatile("s_waitcnt lgkmcnt(0)" ::: "memory");
        bf16* Ow = MIX + (unsigned)((b * SEQ + 128 * n + 32 * i) * DM + head * 64);
#pragma unroll
        for (int r = 0; r < 16; ++r) { const int orow = crow(r, hi); const float rl = __builtin_amdgcn_rcpf(ll[orow]);
#pragma unroll
            for (int d0 = 0; d0 < 2; ++d0) { const float v = o[d0][r] * rl; const float vn = __shfl_xor(v, 1);
                if ((r32 & 1) == 0) *(GAS unsigned*)(Ow + (unsigned)(orow * DM + d0 * 32 + r32)) = cvtpk(v, vn); } }
        asm volatile("s_waitcnt lgkmcnt(0)" ::: "memory");
    }
    __syncthreads();
}
#undef SBAR
#undef KSWZ
}

__device__ __forceinline__ void attn_phase(Frame& F) {
    att::lptr lds = (att::lptr)(F.lds + RING_OFF);
    const float* sinks = in_ptr(F, 6);
#if !NAIVE_SWA
    { const int b = F.vcu >> 6, hk = (F.vcu >> 5) & 1, n = F.vcu & 31;
      att::swa_unit(WSP(bf16, WS_QA), WSP(bf16, WS_KA), WSP(bf16, WS_VA), WSP(float, WS_BIAS), sinks, WSP(bf16, WS_MIX), b, hk, n, lds); }
#endif
#if !NAIVE_MLA
    { const int bh = F.vcu >> 3, s = F.vcu & 7, b = bh >> 3, h = bh & 7;
      for (int pass = 0; pass < 2; ++pass) { const int qb = pass ? 15 - s : s, q0 = qb * att::QB;
          att::mla_unit(WSP(bf16, WS_QB) + (size_t)(b * SEQ + q0) * NQB + h * 192, WSP(bf16, WS_KN) + (size_t)b * SEQ * 1024 + h * 128, WSP(bf16, WS_KR) + (size_t)b * SEQ * 64,
                        WSP(bf16, WS_VB) + (size_t)b * SEQ * 1024 + h * 128, WSP(bf16, WS_MIX) + (size_t)(b * SEQ + q0) * DM + 1024 + h * 128, q0, lds); } }
#endif
}

struct Args { const float* in[17]; float* out; unsigned char* ws; int ph_lo, ph_hi, li, pad; };
__global__ void __launch_bounds__(NWAVES * 64, 2) hymba_fwd(Args args) {
    extern __shared__ __attribute__((aligned(16))) unsigned char lds[];
    Frame F;
    F.lds = (LAS unsigned char*)lds;
    F.MISC = (volatile LAS unsigned*)(F.lds + MISC_OFF);
    F.tid = threadIdx.x; F.lane = F.tid & 63; F.wave = __builtin_amdgcn_readfirstlane(F.tid >> 6);
    F.G = gridDim.x; { const int bx = blockIdx.x; F.vcu = (F.G % 8 == 0) ? (bx % 8) * (F.G / 8) + bx / 8 : bx; }
    unsigned char* ws = args.ws;
    F.ctl = (gu32*)(ws + WS_CTL);
    F.out = args.out; F.ws = ws;
    for (int u = F.tid; u < (LDS_EXTRA_OFF - LDSCTL_OFF) / 4; u += NWAVES * 64) ((LAS unsigned*)(F.lds + LDSCTL_OFF))[u] = 0u;
    __syncthreads();
    if (F.tid == 0) { LAS unsigned long long* t = (LAS unsigned long long*)(F.lds + INPTR_OFF);
#pragma unroll
        for (int k = 0; k < 17; ++k) t[k] = (unsigned long long)(uintptr_t)args.in[k]; }
    __syncthreads();
    XcdBarrier bar; bar.bar = (unsigned*)(F.ctl + CW_BAR); bar.x = 0; bar.st = nullptr;
    if (N_LAUNCHES != PER_PHASE) bar = xcd_barrier_post((unsigned*)(F.ctl + CW_BAR), F.MISC + 8);
#define GRID_BAR(seam) do { if (N_LAUNCHES == PER_PHASE) { if (F.tid == 0) __hip_atomic_store(F.ctl + CW_TMO, 0xBADBA0u | (unsigned)(seam), RLX_AGENT); } else { xcd_barrier(bar); } } while (0)
    const int lo = args.ph_lo, hi = args.ph_hi;
#ifndef ONLY_PHASE
#define ONLY_PHASE -1
#endif
#define IN(k) ((ONLY_PHASE < 0 || ONLY_PHASE == (k)) && lo <= (k) && (k) < hi)
#define BOTH(k) (IN(k) && IN((k) + 1))
#ifndef REP_PHASE
#define REP_PHASE -1
#endif
#define REPS(k) for (int rep_ = 0; rep_ < ((REP_PHASE) == (k) ? 2 : 1); ++rep_)
    const bool grid_ok = (F.G == 256);

    if (IN(0)) { REPS(0) { p0_prologue(F); __syncthreads(); } if (BOTH(0)) GRID_BAR(0); }
    if (IN(1)) { REPS(1) { if (grid_ok) norm_mod_phase<true>(F, in_ptr(F, 0), in_ptr(F, 4), 0, 1); __syncthreads(); } if (BOTH(1)) GRID_BAR(1); }
    if (IN(2)) { REPS(2) {
#if NAIVE_GEMM
        EpiIn<true> f{WSP(bf16, WS_QA), WSP(bf16, WS_KA), WSP(bf16, WS_VA), WSP(bf16, WS_CQ), WSP(bf16, WS_CKV), WSP(bf16, WS_KR), WSP(float, WS_SSQ), WSP(float, WS_ROPE)};
        naive_gemm(F, WSP(bf16, WS_XN), WSP(bf16, WS_WIN), M, IN_PAD, DM, f);
#else
        pg8::Gemm g{WSP(bf16, WS_XN), WSP(bf16, WS_WIN), M, IN_PAD, DM}; pg8::StaticOrder S; S.init(M, IN_PAD, F.G, (int)blockIdx.x);
        pg8::EpiRow<EpiIn<false>> E{{WSP(bf16, WS_QA), WSP(bf16, WS_KA), WSP(bf16, WS_VA), WSP(bf16, WS_CQ), WSP(bf16, WS_CKV), WSP(bf16, WS_KR), WSP(float, WS_SSQ), WSP(float, WS_ROPE)}};
        pg8::gemm_phase<pg8::EpiRow<EpiIn<false>>, pg8::StaticOrder, PG8_ALIGN, PG8_SP2>(F.lds + RING_OFF, g, S, E);
#endif
        __syncthreads(); }
        if (BOTH(2)) GRID_BAR(2);
    }
    if (IN(3)) { REPS(3) {
        for (int gi = 0; gi < 2; ++gi) {
            EpiUp f{WSP(bf16, WS_QB), WSP(bf16, WS_KN), WSP(bf16, WS_VB), WSP(float, WS_SSQ), WSP(float, WS_ROPE), gi};
            const bf16* A = gi ? WSP(bf16, WS_CKV) : WSP(bf16, WS_CQ); const bf16* Bt = gi ? WSP(bf16, WS_WUKV) : WSP(bf16, WS_WUQ);
            const int N = gi ? NKVB : NQB, K = gi ? KVRANK : QRANK;
#if NAIVE_GEMM
            naive_gemm(F, A, Bt, M, N, K, f);
#else
            pg8::Gemm g{A, Bt, M, N, K}; pg8::StaticOrder S; S.init(M, N, F.G, (int)blockIdx.x);
            pg8::EpiRow<EpiUp> E{f}; pg8::gemm_phase<pg8::EpiRow<EpiUp>, pg8::StaticOrder, PG8_ALIGN, PG8_SP2>(F.lds + RING_OFF, g, S, E);
#endif
        }
        __syncthreads(); }
        if (BOTH(3)) GRID_BAR(3);
    }
    if (IN(4)) { REPS(4) {
#if NAIVE_SWA
        naive_swa(F);
#endif
#if NAIVE_MLA
        naive_mla(F);
#endif
        __syncthreads();
        if (grid_ok) attn_phase(F);
        __syncthreads(); }
        if (BOTH(4)) GRID_BAR(4);
    }
    if (IN(5)) { REPS(5) {
        EpiRes f{in_ptr(F, 0), F.out, WSP(float, WS_MOD) + 2 * DM};
#if NAIVE_GEMM
        naive_gemm(F, WSP(bf16, WS_MIX), WSP(bf16, WS_WOUT), M, DM, DM, f);
#else
        pg8::Gemm g{WSP(bf16, WS_MIX), WSP(bf16, WS_WOUT), M, DM, DM}; pg8::StaticOrder S; S.init(M, DM, F.G, (int)blockIdx.x);
        pg8::EpiRow<EpiRes> E{f}; pg8::gemm_phase<pg8::EpiRow<EpiRes>, pg8::StaticOrder, PG8_ALIGN, PG8_SP2>(F.lds + RING_OFF, g, S, E);
#endif
        __syncthreads(); }
        if (BOTH(5)) GRID_BAR(5);
    }
    if (IN(6)) { if (grid_ok) norm_mod_phase<false>(F, F.out, in_ptr(F, 13), 3, 4); __syncthreads(); if (BOTH(6)) GRID_BAR(6); }
    if (IN(7)) { REPS(7) {
        EpiRelu2 f{WSP(bf16, WS_H)};
#if NAIVE_GEMM
        naive_gemm(F, WSP(bf16, WS_XN), WSP(bf16, WS_W1), M, FF, DM, f);
#else
        pg8::Gemm g{WSP(bf16, WS_XN), WSP(bf16, WS_W1), M, FF, DM}; pg8::StaticOrder S; S.init(M, FF, F.G, (int)blockIdx.x);
        pg8::EpiRow<EpiRelu2> E{f}; pg8::gemm_phase<pg8::EpiRow<EpiRelu2>, pg8::StaticOrder, PG8_ALIGN, PG8_SP2>(F.lds + RING_OFF, g, S, E);
#endif
        __syncthreads(); }
        if (BOTH(7)) GRID_BAR(7);
    }
    if (IN(8)) {
        EpiRes f{F.out, F.out, WSP(float, WS_MOD) + 5 * DM};
#if NAIVE_GEMM
        naive_gemm(F, WSP(bf16, WS_H), WSP(bf16, WS_W2), M, DM, FF, f);
#else
        pg8::Gemm g{WSP(bf16, WS_H), WSP(bf16, WS_W2), M, DM, FF}; pg8::StaticOrder S; S.init(M, DM, F.G, (int)blockIdx.x);
        pg8::EpiRow<EpiRes> E{f}; pg8::gemm_phase<pg8::EpiRow<EpiRes>, pg8::StaticOrder, PG8_ALIGN, PG8_SP2>(F.lds + RING_OFF, g, S, E);
#endif
        if (BOTH(8)) GRID_BAR(8);
    }
    if (IN(9)) {
        bool bad = !grid_ok || __hip_atomic_load(F.ctl + CW_TMO, RLX_AGENT) != 0u || __hip_atomic_load((gu32*)((unsigned*)(F.ctl + CW_BAR) + XB_TMO), RLX_AGENT) != 0u;
        if (bad) nan_rows_f32(F, F.out); else final_norm_phase(F);
    }
#undef IN
#undef BOTH
}

extern "C" void kernel_launch(void* const* d_in, const int* in_sizes, int n_in, void* d_out, int out_size, void* d_ws, size_t ws_size, hipStream_t stream) {
    static int grid = 0;
    if (grid == 0) {
        if (n_in != 17 || in_sizes[0] != M * DM || out_size != M * DM || ws_size < WS_END) { fprintf(stderr, "kernel_launch: shape mismatch (n_in %d, in0 %d, out %d, ws %zu)\n", n_in, n_in > 0 ? in_sizes[0] : -1, out_size, ws_size); grid = -1; return; }
        int dev = 0, cus = 0;
        if (hipGetDevice(&dev) != hipSuccess || hipDeviceGetAttribute(&cus, hipDeviceAttributeMultiprocessorCount, dev) != hipSuccess) { grid = -1; return; }
        if (hipFuncSetAttribute((const void*)hymba_fwd, hipFuncAttributeMaxDynamicSharedMemorySize, LDS_BYTES) != hipSuccess) { fprintf(stderr, "kernel_launch: hipFuncSetAttribute failed\n"); grid = -1; return; }
        (void)hipGetLastError();
        grid = cus;
        if (grid != 256) fprintf(stderr, "kernel_launch: %d CUs; this kernel is built for 256\n", grid);
    }
    if (grid < 0) return;
    if (hipMemsetAsync((char*)d_ws + WS_CTL, 0, CTL_ZERO_BYTES, stream) != hipSuccess) { fprintf(stderr, "kernel_launch: memset failed\n"); return; }
    Args a{};
    for (int i = 0; i < 17; ++i) a.in[i] = (const float*)d_in[i];
    a.out = (float*)d_out; a.ws = (unsigned char*)d_ws;
    for (int li = 0; li < N_LAUNCHES; ++li) {
        if (N_LAUNCHES == PER_PHASE) { a.ph_lo = li; a.ph_hi = li + 1; } else { a.ph_lo = 0; a.ph_hi = PER_PHASE; }
        a.li = li;
        hipLaunchKernelGGL(hymba_fwd, dim3(grid), dim3(NWAVES * 64), LDS_BYTES, stream, a);
        const hipError_t le = hipPeekAtLastError();
        if (le != hipSuccess) { fprintf(stderr, "kernel_launch: launch %d failed: %s\n", li, hipGetErrorName(le)); break; }
    }
}
```
